# Optimizing an MI355X kernel written in HIP

```python
import math
import jax
import jax.numpy as jnp
from jax import lax
import numpy as np


D_MODEL = 1024
BATCH = 8
SEQ = 2048
DEPTH = 1

MEM_TOKENS = 256
GRID_W = 64
Q_BLOCK = 128
ROPE_THETA = 10000.0

A_HEADS = 8
A_KV_HEADS = 2
A_GROUP = A_HEADS // A_KV_HEADS
A_HEAD_DIM = D_MODEL // 16
D_A = A_HEADS * A_HEAD_DIM

B_HEADS = 4
B_HEAD_DIM = D_MODEL // 16
B_VDIM = 2 * B_HEAD_DIM
D_B = B_HEADS * B_VDIM

D_MIX = D_A + D_B

A_Q_COLS = A_HEADS * A_HEAD_DIM
A_KV_COLS = A_KV_HEADS * A_HEAD_DIM
B_QK_COLS = B_HEADS * 2 * B_HEAD_DIM
B_V_COLS = B_HEADS * B_VDIM
D_IN_PROJ = A_Q_COLS + 2 * A_KV_COLS + 2 * B_QK_COLS + B_V_COLS
IN_SPLITS = (A_Q_COLS,
             A_Q_COLS + A_KV_COLS,
             A_Q_COLS + 2 * A_KV_COLS,
             A_Q_COLS + 2 * A_KV_COLS + B_QK_COLS,
             A_Q_COLS + 2 * A_KV_COLS + 2 * B_QK_COLS)

MEM_HEADS = 4
MEM_HEAD_DIM = D_MODEL // MEM_HEADS

N_EXPERTS = 32
TOP_K = 4
D_FF = D_MODEL
SWIGLU_LIMIT = 7.0
SWIGLU_ALPHA = 1.702

DEEPNORM_ALPHA = (2.0 * DEPTH) ** 0.25
DEEPNORM_BETA = (8.0 * DEPTH) ** -0.25
LN_EPS = 1e-5
RMS_EPS = 1e-6

kernel_name = 'hybrid_gqa_axial_diffattn_memxattn_moe_deepnorm'


def layer_norm(x, g, b):
    xf = x.astype(jnp.float32)
    mu = jnp.mean(xf, axis=-1, keepdims=True)
    xc = xf - mu
    var = jnp.mean(xc * xc, axis=-1, keepdims=True)
    y = xc * lax.rsqrt(var + LN_EPS) * g.astype(jnp.float32) + b.astype(jnp.float32)
    return y.astype(x.dtype)


def rms_norm(x, g):
    xf = x.astype(jnp.float32)
    y = xf * lax.rsqrt(jnp.mean(xf * xf, axis=-1, keepdims=True) + RMS_EPS) * g.astype(jnp.float32)
    return y.astype(x.dtype)


def rope_cos_sin(pos, dim):
    inv = ROPE_THETA ** (-jnp.arange(0, dim, 2, dtype=jnp.float32) / dim)
    ang = pos.astype(jnp.float32)[:, None] * inv[None, :]
    return jnp.cos(ang), jnp.sin(ang)


def apply_rope(x, cos, sin):
    xf = x.astype(jnp.float32)
    x1, x2 = jnp.split(xf, 2, axis=-1)
    return jnp.concatenate([x1 * cos - x2 * sin, x2 * cos + x1 * sin], axis=-1).astype(x.dtype)


def axial_rope(x, cs_row, cs_col):
    half = x.shape[-1] // 2
    return jnp.concatenate([apply_rope(x[..., :half], *cs_row),
                            apply_rope(x[..., half:], *cs_col)], axis=-1)


def sweep_query_blocks(block_fn, q):
    S = q.shape[-2]
    nblk = S // Q_BLOCK
    qb = q.reshape(q.shape[:-2] + (nblk, Q_BLOCK, q.shape[-1]))
    qb = jnp.moveaxis(qb, -3, 0)
    out = lax.map(block_fn, qb)
    out = jnp.moveaxis(out, 0, -3)
    return out.reshape(out.shape[:-3] + (S, out.shape[-1]))


def gqa_axial_attention(q, k, v, q_g, k_g, cs_row, cs_col):
    B, S = q.shape[0], q.shape[1]
    q = axial_rope(rms_norm(q, q_g).transpose(0, 2, 1, 3), cs_row, cs_col)
    k = axial_rope(rms_norm(k, k_g).transpose(0, 2, 1, 3), cs_row, cs_col)
    v = v.transpose(0, 2, 1, 3)
    q = q.reshape(B, A_KV_HEADS, A_GROUP, S, A_HEAD_DIM)
    scale = A_HEAD_DIM ** -0.5

    def block(qb):
        s = jnp.einsum('bkgqd,bksd->bkgqs', qb, k).astype(jnp.float32) * scale
        p = jax.nn.softmax(s, axis=-1).astype(v.dtype)
        return jnp.einsum('bkgqs,bksd->bkgqd', p, v)

    o = sweep_query_blocks(block, q)
    return o.reshape(B, A_HEADS, S, A_HEAD_DIM).transpose(0, 2, 1, 3).reshape(B, S, D_A)


def differential_attention(q, k, v, lq1, lk1, lq2, lk2, subln_g, cs, lambda_init):
    B, S = q.shape[0], q.shape[1]
    q = apply_rope(q.transpose(0, 2, 3, 1, 4), *cs)
    k = apply_rope(k.transpose(0, 2, 3, 1, 4), *cs)
    v = v.transpose(0, 2, 1, 3)
    lam = (jnp.exp(jnp.sum(lq1.astype(jnp.float32) * lk1.astype(jnp.float32)))
           - jnp.exp(jnp.sum(lq2.astype(jnp.float32) * lk2.astype(jnp.float32)))
           + lambda_init)
    scale = B_HEAD_DIM ** -0.5

    def block(qb):
        s = jnp.einsum('bhcqd,bhcsd->bhcqs', qb, k).astype(jnp.float32) * scale
        p = jax.nn.softmax(s, axis=-1)
        a = (p[:, :, 0] - lam * p[:, :, 1]).astype(v.dtype)
        return jnp.einsum('bhqs,bhsv->bhqv', a, v)

    o = sweep_query_blocks(block, q)
    o = rms_norm(o, subln_g) * (1.0 - lambda_init)
    return o.transpose(0, 2, 1, 3).reshape(B, S, D_B)


def memory_cross_attention(x, mem, w_q, w_kv, w_o):
    B, S, D = x.shape
    M = mem.shape[1]
    q = (x @ w_q).reshape(B, S, MEM_HEADS, MEM_HEAD_DIM)
    k, v = jnp.split(mem @ w_kv, 2, axis=-1)
    k = k.reshape(B, M, MEM_HEADS, MEM_HEAD_DIM)
    v = v.reshape(B, M, MEM_HEADS, MEM_HEAD_DIM)
    s = jnp.einsum('bqhd,bmhd->bhqm', q, k).astype(jnp.float32) * (MEM_HEAD_DIM ** -0.5)
    p = jax.nn.softmax(s, axis=-1).astype(v.dtype)
    o = jnp.einsum('bhqm,bmhd->bqhd', p, v).reshape(B, S, D)
    return o @ w_o


def clamped_swiglu(g, u):
    g = jnp.minimum(g, SWIGLU_LIMIT)
    u = jnp.clip(u, -SWIGLU_LIMIT, SWIGLU_LIMIT)
    return g * jax.nn.sigmoid(SWIGLU_ALPHA * g) * (u + 1.0)


def routed_experts(x, w_r, b_r, w_g, b_g, w_u, b_u, w_d, b_d):
    B, S, D = x.shape
    xt = x.reshape(B * S, D)
    logits = (xt @ w_r + b_r).astype(jnp.float32)
    top_v, top_i = lax.top_k(logits, TOP_K)
    gates = jax.nn.softmax(top_v, axis=-1)
    combine = jnp.einsum('nk,nke->ne', gates,
                         jax.nn.one_hot(top_i, N_EXPERTS, dtype=jnp.float32)).astype(x.dtype)
    y = jnp.zeros_like(xt)
    for e in range(N_EXPERTS):
        h = clamped_swiglu(xt @ w_g[e] + b_g[e], xt @ w_u[e] + b_u[e])
        y = y + combine[:, e:e + 1] * (h @ w_d[e] + b_d[e])
    return y.reshape(B, S, D)


def setup_inputs(seed: int = 0) -> dict:
    key = jax.random.key(seed)
    ks = jax.random.split(key, 32)
    L, D, E, F = DEPTH, D_MODEL, N_EXPERTS, D_FF

    def nrm(k, shape, std):
        return std * jax.random.normal(k, shape, jnp.float32)

    def gain(k, shape):
        return 1.0 + nrm(k, shape, 0.02)

    return {
        'x': nrm(ks[0], (BATCH, SEQ, D), 1.0),
        'mem': nrm(ks[1], (BATCH, MEM_TOKENS, D), 1.0),
        'w_in': nrm(ks[2], (L, D, D_IN_PROJ), D ** -0.5),
        'a_q_norm': gain(ks[3], (L, A_HEAD_DIM)),
        'a_k_norm': gain(ks[4], (L, A_HEAD_DIM)),
        'b_lambda_q1': nrm(ks[5], (L, B_HEAD_DIM), 0.1),
        'b_lambda_k1': nrm(ks[6], (L, B_HEAD_DIM), 0.1),
        'b_lambda_q2': nrm(ks[7], (L, B_HEAD_DIM), 0.1),
        'b_lambda_k2': nrm(ks[8], (L, B_HEAD_DIM), 0.1),
        'b_subln': gain(ks[9], (L, B_VDIM)),
        'w_mix_out': nrm(ks[10], (L, D_MIX, D), D_MIX ** -0.5 * DEEPNORM_BETA),
        'ln1_g': gain(ks[11], (L, D)),
        'ln1_b': nrm(ks[12], (L, D), 0.02),
        'w_mem_q': nrm(ks[13], (L, D, D), D ** -0.5),
        'w_mem_kv': nrm(ks[14], (L, D, 2 * D), D ** -0.5),
        'w_mem_out': nrm(ks[15], (L, D, D), D ** -0.5 * DEEPNORM_BETA),
        'ln2_g': gain(ks[16], (L, D)),
        'ln2_b': nrm(ks[17], (L, D), 0.02),
        'w_router': nrm(ks[18], (L, D, E), D ** -0.5),
        'b_router': nrm(ks[19], (L, E), 0.01),
        'w_e_gate': nrm(ks[20], (L, E, D, F), D ** -0.5),
        'b_e_gate': nrm(ks[21], (L, E, F), 0.02),
        'w_e_up': nrm(ks[22], (L, E, D, F), D ** -0.5),
        'b_e_up': nrm(ks[23], (L, E, F), 0.02),
        'w_e_down': nrm(ks[24], (L, E, F, D), F ** -0.5 * DEEPNORM_BETA),
        'b_e_down': nrm(ks[25], (L, E, D), 0.02),
        'ln3_g': gain(ks[26], (L, D)),
        'ln3_b': nrm(ks[27], (L, D), 0.02),
    }


def reference(x, mem, w_in, a_q_norm, a_k_norm, b_lambda_q1, b_lambda_k1, b_lambda_q2,
              b_lambda_k2, b_subln, w_mix_out, ln1_g, ln1_b, w_mem_q, w_mem_kv, w_mem_out,
              ln2_g, ln2_b, w_router, b_router, w_e_gate, b_e_gate, w_e_up, b_e_up,
              w_e_down, b_e_down, ln3_g, ln3_b):
    B, S, D = x.shape
    ROWS = S // GRID_W
    grid = jnp.stack(jnp.meshgrid(jnp.arange(ROWS, dtype=jnp.int32),
                                  jnp.arange(GRID_W, dtype=jnp.int32), indexing='ij'), axis=-1)
    grid = grid.reshape(S, 2)
    cs_row = rope_cos_sin(grid[:, 0], A_HEAD_DIM // 2)
    cs_col = rope_cos_sin(grid[:, 1], A_HEAD_DIM // 2)
    cs_seq = rope_cos_sin(jnp.arange(S, dtype=jnp.int32), B_HEAD_DIM)

    for layer in range(DEPTH):
        lambda_init = 0.8 - 0.6 * math.exp(-0.3 * layer)
        h = x @ w_in[layer]
        qa, ka, va, qb, kb, vb = jnp.split(h, IN_SPLITS, axis=-1)
        out_a = gqa_axial_attention(qa.reshape(B, S, A_HEADS, A_HEAD_DIM),
                                    ka.reshape(B, S, A_KV_HEADS, A_HEAD_DIM),
                                    va.reshape(B, S, A_KV_HEADS, A_HEAD_DIM),
                                    a_q_norm[layer], a_k_norm[layer], cs_row, cs_col)
        out_b = differential_attention(qb.reshape(B, S, B_HEADS, 2, B_HEAD_DIM),
                                       kb.reshape(B, S, B_HEADS, 2, B_HEAD_DIM),
                                       vb.reshape(B, S, B_HEADS, B_VDIM),
                                       b_lambda_q1[layer], b_lambda_k1[layer],
                                       b_lambda_q2[layer], b_lambda_k2[layer],
                                       b_subln[layer], cs_seq, lambda_init)
        mix = jnp.concatenate([out_a, out_b], axis=-1) @ w_mix_out[layer]
        x = layer_norm(DEEPNORM_ALPHA * x + mix, ln1_g[layer], ln1_b[layer])
        xa = memory_cross_attention(x, mem, w_mem_q[layer], w_mem_kv[layer], w_mem_out[layer])
        x = layer_norm(DEEPNORM_ALPHA * x + xa, ln2_g[layer], ln2_b[layer])
        ff = routed_experts(x, w_router[layer], b_router[layer], w_e_gate[layer], b_e_gate[layer],
                            w_e_up[layer], b_e_up[layer], w_e_down[layer], b_e_down[layer])
        x = layer_norm(DEEPNORM_ALPHA * x + ff, ln3_g[layer], ln3_b[layer])
    return x
```

```cpp
#include <hip/hip_runtime.h>
#include <cstdio>
#include <cstdint>

namespace v0 {
constexpr int NB = 8, SEQ = 2048, DM = 1024, NTOK = NB * SEQ, MEMT = 256, DIN = 2304, NE = 32, TOPK = 4, CAP = NTOK;
constexpr float ALPHA = 1.189207115002721f;
constexpr float LN_EPS = 1e-5f, RMS_EPS = 1e-6f;
constexpr float LAMBDA_INIT = 0.2f;

__device__ __forceinline__ float wave_sum(float v) {
#pragma unroll
    for (int o = 1; o < 64; o <<= 1) v += __shfl_xor(v, o);
    return v;
}
__device__ __forceinline__ float wave_max(float v) {
#pragma unroll
    for (int o = 1; o < 64; o <<= 1) v = fmaxf(v, __shfl_xor(v, o));
    return v;
}

struct GemmArgs {
    const float* A; const float* B; const float* B2; float* C;
    const float* bias; const float* bias2; const float* R;
    const int* rowidx; const int* Mdev; const int* offdev; const float* gate;
    float alpha;
    int M, N, K, lda, ldb, ldc, transB, nz2, aoff_dev, coff_dev;
    long a1, a2, b1, b2, c1, c2, bias1, idx1;
};

template <int MODE>
__global__ void __launch_bounds__(256) k_gemm(GemmArgs g) {
    __shared__ float As[16][68];
    __shared__ float Bs[16][68];
    __shared__ float Bs2[MODE == 2 ? 16 : 1][68];
    const int z = blockIdx.z, z1 = z / g.nz2, z2 = z % g.nz2;
    const int M = g.Mdev ? g.Mdev[z] : g.M;
    const int m0 = blockIdx.y * 64, n0 = blockIdx.x * 64;
    if (m0 >= M) return;
    const float* A = g.A + z1 * g.a1 + z2 * g.a2;
    const float* B = g.B + z1 * g.b1 + z2 * g.b2;
    const float* B2 = MODE == 2 ? g.B2 + z1 * g.b1 + z2 * g.b2 : nullptr;
    float* C = g.C + z1 * g.c1 + z2 * g.c2;
    const long doff = g.offdev ? (long)g.offdev[z] : 0;
    const long aoff = g.aoff_dev ? doff : 0, coff = g.coff_dev ? doff : 0;
    const int* idx = g.rowidx ? g.rowidx + (long)z * g.idx1 : nullptr;
    const int tid = threadIdx.x, tx = tid & 15, ty = tid >> 4;
    float acc[4][4], acc2[4][4];
#pragma unroll
    for (int i = 0; i < 4; ++i)
#pragma unroll
        for (int j = 0; j < 4; ++j) { acc[i][j] = 0.f; acc2[i][j] = 0.f; }
    for (int k0 = 0; k0 < g.K; k0 += 16) {
        {
            const int r = tid >> 2, kq = (tid & 3) * 4, m = m0 + r;
            float4 v = make_float4(0.f, 0.f, 0.f, 0.f);
            if (m < M) { const long row = (idx && MODE != 3) ? (long)idx[m] : (aoff + m); v = *(const float4*)(A + row * g.lda + k0 + kq); }
            As[kq + 0][r] = v.x; As[kq + 1][r] = v.y; As[kq + 2][r] = v.z; As[kq + 3][r] = v.w;
        }
        if (g.transB) {
            const int n = tid >> 2, kq = (tid & 3) * 4;
            float4 v = make_float4(0.f, 0.f, 0.f, 0.f);
            if (n0 + n < g.N) v = *(const float4*)(B + (long)(n0 + n) * g.ldb + k0 + kq);
            Bs[kq + 0][n] = v.x; Bs[kq + 1][n] = v.y; Bs[kq + 2][n] = v.z; Bs[kq + 3][n] = v.w;
        } else {
            const int k = tid >> 4, nq = (tid & 15) * 4;
            float4 v = make_float4(0.f, 0.f, 0.f, 0.f);
            if (n0 + nq < g.N) v = *(const float4*)(B + (long)(k0 + k) * g.ldb + n0 + nq);
            Bs[k][nq + 0] = v.x; Bs[k][nq + 1] = v.y; Bs[k][nq + 2] = v.z; Bs[k][nq + 3] = v.w;
            if (MODE == 2) {
                float4 w = *(const float4*)(B2 + (long)(k0 + k) * g.ldb + n0 + nq);
                Bs2[k][nq + 0] = w.x; Bs2[k][nq + 1] = w.y; Bs2[k][nq + 2] = w.z; Bs2[k][nq + 3] = w.w;
            }
        }
        __syncthreads();
#pragma unroll
        for (int kk = 0; kk < 16; ++kk) {
            float a[4], b[4], b2[4];
#pragma unroll
            for (int i = 0; i < 4; ++i) a[i] = As[kk][ty * 4 + i];
#pragma unroll
            for (int j = 0; j < 4; ++j) b[j] = Bs[kk][tx * 4 + j];
            if (MODE == 2) {
#pragma unroll
                for (int j = 0; j < 4; ++j) b2[j] = Bs2[kk][tx * 4 + j];
            }
#pragma unroll
            for (int i = 0; i < 4; ++i)
#pragma unroll
                for (int j = 0; j < 4; ++j) { acc[i][j] += a[i] * b[j]; if (MODE == 2) acc2[i][j] += a[i] * b2[j]; }
        }
        __syncthreads();
    }
    const float* bias = g.bias ? g.bias + (long)z * g.bias1 : nullptr;
    const float* bias2 = (MODE == 2 && g.bias2) ? g.bias2 + (long)z * g.bias1 : nullptr;
#pragma unroll
    for (int i = 0; i < 4; ++i) {
        const int m = m0 + ty * 4 + i;
        if (m >= M) continue;
#pragma unroll
        for (int j = 0; j < 4; ++j) {
            const int n = n0 + tx * 4 + j;
            if (n >= g.N) continue;
            float v = acc[i][j] + (bias ? bias[n] : 0.f);
            if (MODE == 0) { C[(coff + m) * g.ldc + n] = v; }
            else if (MODE == 1) { C[(coff + m) * g.ldc + n] = g.alpha * g.R[(long)m * g.ldc + n] + v; }
            else if (MODE == 2) {
                float gg = fminf(v, 7.0f);
                float uu = acc2[i][j] + (bias2 ? bias2[n] : 0.f);
                uu = fminf(fmaxf(uu, -7.0f), 7.0f);
                const float sg = 1.0f / (1.0f + expf(-1.702f * gg));
                C[(coff + m) * g.ldc + n] = gg * sg * (uu + 1.0f);
            } else if (MODE == 3) {
                const int tok = idx[m];
                const float gt = g.gate[(long)z * g.idx1 + m];
                atomicAdd(&C[(long)tok * g.ldc + n], gt * v);
            } else { C[(coff + m) * g.ldc + n] = v * g.alpha; }
        }
    }
}

__global__ void __launch_bounds__(256) k_norm_rope(const float* __restrict__ h, const float* __restrict__ gq, const float* __restrict__ gk,
                                                   float* QA, float* KA, float* QB, float* KB) {
    const int lane = threadIdx.x & 63, w = threadIdx.x >> 6;
    const long item = (long)blockIdx.x * 4 + w;
    if (item >= (long)NTOK * 26) return;
    const int t = (int)(item / 26), slot = (int)(item % 26), s = t % SEQ;
    const float* hr = h + (long)t * DIN;
    if (slot < 10) {
        const bool isq = slot < 8;
        const int col0 = isq ? slot * 64 : 512 + (slot - 8) * 64;
        const float v = hr[col0 + lane];
        const float ss = wave_sum(v * v);
        const float y = v * (1.0f / sqrtf(ss * (1.0f / 64.0f) + RMS_EPS)) * (isq ? gq[lane] : gk[lane]);
        const int sub = lane >> 5, j = lane & 31, i = j & 15;
        const int pos = sub == 0 ? (s >> 6) : (s & 63);
        const float inv = powf(10000.0f, -(float)(2 * i) / 32.0f);
        const float ang = (float)pos * inv;
        const float c = cosf(ang), sn = sinf(ang);
        const float p = __shfl_xor(y, 16);
        const float o = (j < 16) ? (y * c - p * sn) : (y * c + p * sn);
        if (isq) QA[(long)t * 512 + slot * 64 + lane] = o; else KA[(long)t * 128 + (slot - 8) * 64 + lane] = o;
    } else {
        const bool isq = slot < 18;
        const int hc = isq ? slot - 10 : slot - 18;
        const int col0 = (isq ? 768 : 1280) + hc * 64;
        const float v = hr[col0 + lane];
        const int i = lane & 31;
        const float inv = powf(10000.0f, -(float)(2 * i) / 64.0f);
        const float ang = (float)s * inv;
        const float c = cosf(ang), sn = sinf(ang);
        const float p = __shfl_xor(v, 32);
        const float o = (lane < 32) ? (v * c - p * sn) : (v * c + p * sn);
        if (isq) QB[(long)t * 512 + hc * 64 + lane] = o; else KB[(long)t * 512 + hc * 64 + lane] = o;
    }
}

template <int DV>
__global__ void __launch_bounds__(64) k_attn(const float* __restrict__ Q, int ldq, const float* __restrict__ K, int ldk, int kgroup,
                                             const float* __restrict__ V, int ldv, int vgroup, int vstride, float* O, int diffmode, float scale) {
    __shared__ float Ks[32][64];
    __shared__ float Vs[32][DV];
    const int lane = threadIdx.x, y = blockIdx.y, b = blockIdx.z;
    const long t = (long)b * SEQ + blockIdx.x * 64 + lane;
    const float* qp = Q + t * ldq + y * 64;
    const float* kb = K + (long)b * SEQ * ldk + (y / kgroup) * 64;
    const float* vb = V + (long)b * SEQ * ldv + (y / vgroup) * vstride;
    float q[64], o[DV];
#pragma unroll
    for (int d = 0; d < 64; d += 4) { const float4 v = *(const float4*)(qp + d); q[d] = v.x * scale; q[d + 1] = v.y * scale; q[d + 2] = v.z * scale; q[d + 3] = v.w * scale; }
#pragma unroll
    for (int d = 0; d < DV; ++d) o[d] = 0.f;
    float m = -INFINITY, l = 0.f;
    for (int kt = 0; kt < SEQ; kt += 32) {
        __syncthreads();
#pragma unroll
        for (int i = 0; i < 8; ++i) { const int e = i * 64 + lane, r = e >> 4, c4 = (e & 15) * 4; *(float4*)&Ks[r][c4] = *(const float4*)(kb + (long)(kt + r) * ldk + c4); }
#pragma unroll
        for (int i = 0; i < DV / 8; ++i) { const int e = i * 64 + lane, r = e / (DV / 4), c4 = (e % (DV / 4)) * 4; *(float4*)&Vs[r][c4] = *(const float4*)(vb + (long)(kt + r) * ldv + c4); }
        __syncthreads();
        for (int j = 0; j < 32; ++j) {
            float s = 0.f;
#pragma unroll
            for (int d = 0; d < 64; d += 4) { const float4 kv = *(const float4*)&Ks[j][d]; s += q[d] * kv.x + q[d + 1] * kv.y + q[d + 2] * kv.z + q[d + 3] * kv.w; }
            const float mn = fmaxf(m, s);
            const float corr = expf(m - mn), p = expf(s - mn);
            l = l * corr + p; m = mn;
#pragma unroll
            for (int d = 0; d < DV; d += 4) { const float4 vv = *(const float4*)&Vs[j][d];
                o[d] = o[d] * corr + p * vv.x; o[d + 1] = o[d + 1] * corr + p * vv.y; o[d + 2] = o[d + 2] * corr + p * vv.z; o[d + 3] = o[d + 3] * corr + p * vv.w; }
        }
    }
    const float rl = 1.0f / l;
    float* op;
    if (diffmode) op = O + (long)(y & 1) * ((long)NTOK * 512) + t * 512 + (y >> 1) * 128;
    else op = O + t * 1024 + y * 64;
#pragma unroll
    for (int d = 0; d < DV; d += 4) *(float4*)(op + d) = make_float4(o[d] * rl, o[d + 1] * rl, o[d + 2] * rl, o[d + 3] * rl);
}

__global__ void __launch_bounds__(256) k_diff_combine(const float* __restrict__ OT, const float* lq1, const float* lk1, const float* lq2, const float* lk2,
                                                      const float* __restrict__ subg, float* AO) {
    const int lane = threadIdx.x & 63, w = threadIdx.x >> 6;
    const long item = (long)blockIdx.x * 4 + w;
    if (item >= (long)NTOK * 4) return;
    const float lam = expf(wave_sum(lq1[lane] * lk1[lane])) - expf(wave_sum(lq2[lane] * lk2[lane])) + LAMBDA_INIT;
    const int t = (int)(item >> 2), hh = (int)(item & 3);
    const float* o1 = OT + (long)t * 512 + hh * 128;
    const float* o2 = o1 + (long)NTOK * 512;
    const float v0 = o1[lane] - lam * o2[lane], v1 = o1[lane + 64] - lam * o2[lane + 64];
    const float ss = wave_sum(v0 * v0 + v1 * v1);
    const float r = 1.0f / sqrtf(ss * (1.0f / 128.0f) + RMS_EPS);
    float* out = AO + (long)t * 1024 + 512 + hh * 128;
    out[lane] = v0 * r * subg[lane] * (1.0f - LAMBDA_INIT);
    out[lane + 64] = v1 * r * subg[lane + 64] * (1.0f - LAMBDA_INIT);
}

__global__ void __launch_bounds__(256) k_ln(const float* in, const float* __restrict__ g, const float* __restrict__ bta, float* out, float* out2, float a2, int rows) {
    const int lane = threadIdx.x & 63, w = threadIdx.x >> 6;
    const int row = blockIdx.x * 4 + w;
    if (row >= rows) return;
    const float4* xr = (const float4*)(in + (long)row * DM) + lane;
    float4 v[4]; float s = 0.f;
#pragma unroll
    for (int j = 0; j < 4; ++j) { v[j] = xr[64 * j]; s += (v[j].x + v[j].y) + (v[j].z + v[j].w); }
    const float mean = wave_sum(s) * (1.0f / DM); float s2 = 0.f;
#pragma unroll
    for (int j = 0; j < 4; ++j) { v[j].x -= mean; v[j].y -= mean; v[j].z -= mean; v[j].w -= mean; s2 += (v[j].x * v[j].x + v[j].y * v[j].y) + (v[j].z * v[j].z + v[j].w * v[j].w); }
    const float rstd = 1.0f / sqrtf(wave_sum(s2) * (1.0f / DM) + LN_EPS);
#pragma unroll
    for (int j = 0; j < 4; ++j) {
        const float4 gg = ((const float4*)g)[lane + 64 * j], bb = ((const float4*)bta)[lane + 64 * j];
        float4 o; o.x = v[j].x * rstd * gg.x + bb.x; o.y = v[j].y * rstd * gg.y + bb.y; o.z = v[j].z * rstd * gg.z + bb.z; o.w = v[j].w * rstd * gg.w + bb.w;
        ((float4*)(out + (long)row * DM))[lane + 64 * j] = o;
        if (out2) ((float4*)(out2 + (long)row * DM))[lane + 64 * j] = make_float4(a2 * o.x, a2 * o.y, a2 * o.z, a2 * o.w);
    }
}

__global__ void __launch_bounds__(256) k_softmax256(float* S, long nrows) {
    const int lane = threadIdx.x & 63, w = threadIdx.x >> 6;
    const long row = (long)blockIdx.x * 4 + w;
    if (row >= nrows) return;
    float4* p = (float4*)(S + row * 256) + lane;
    float4 v = *p;
    const float mx = wave_max(fmaxf(fmaxf(v.x, v.y), fmaxf(v.z, v.w)));
    v.x = expf(v.x - mx); v.y = expf(v.y - mx); v.z = expf(v.z - mx); v.w = expf(v.w - mx);
    const float r = 1.0f / wave_sum((v.x + v.y) + (v.z + v.w));
    v.x *= r; v.y *= r; v.z *= r; v.w *= r;
    *p = v;
}

__global__ void __launch_bounds__(256) k_topk(const float* __restrict__ logits, int* cnt, int* list, float* glist) {
    const int t = blockIdx.x * 256 + threadIdx.x;
    if (t >= NTOK) return;
    float lg[NE];
#pragma unroll
    for (int e = 0; e < NE; e += 4) { const float4 v = *(const float4*)(logits + (long)t * NE + e); lg[e] = v.x; lg[e + 1] = v.y; lg[e + 2] = v.z; lg[e + 3] = v.w; }
    int sel[TOPK]; float sv[TOPK];
#pragma unroll
    for (int k = 0; k < TOPK; ++k) {
        float best = -INFINITY; int bi = 0;
#pragma unroll
        for (int e = 0; e < NE; ++e) { const bool taken = (k > 0 && sel[0] == e) || (k > 1 && sel[1] == e) || (k > 2 && sel[2] == e); if (!taken && lg[e] > best) { best = lg[e]; bi = e; } }
        sel[k] = bi; sv[k] = best;
    }
    const float mx = sv[0];
    float ex[TOPK], sum = 0.f;
#pragma unroll
    for (int k = 0; k < TOPK; ++k) { ex[k] = expf(sv[k] - mx); sum += ex[k]; }
#pragma unroll
    for (int k = 0; k < TOPK; ++k) {
        const int pos = atomicAdd(&cnt[sel[k]], 1);
        list[(long)sel[k] * CAP + pos] = t;
        glist[(long)sel[k] * CAP + pos] = ex[k] / sum;
    }
}
__global__ void k_offsets(const int* cnt, int* off) {
    if (threadIdx.x == 0 && blockIdx.x == 0) { int a = 0; for (int e = 0; e < NE; ++e) { off[e] = a; a += cnt[e]; } }
}
}

extern "C" void kernel_launch(void* const* d_in, const int* in_sizes, int n_in, void* d_out, int out_size, void* d_ws, size_t ws_size, hipStream_t stream) {
    using namespace v0;
    constexpr size_t MiB = 1u << 20;
    if (n_in != 28 || out_size != NTOK * DM || ws_size < 512 * MiB) { fprintf(stderr, "kernel_launch: unexpected shapes (n_in %d out %d ws %zu)\n", n_in, out_size, ws_size); return; }
    const float* x = (const float*)d_in[0]; const float* mem = (const float*)d_in[1]; const float* w_in = (const float*)d_in[2];
    const float* a_q_norm = (const float*)d_in[3]; const float* a_k_norm = (const float*)d_in[4];
    const float* lq1 = (const float*)d_in[5]; const float* lk1 = (const float*)d_in[6]; const float* lq2 = (const float*)d_in[7]; const float* lk2 = (const float*)d_in[8];
    const float* subln = (const float*)d_in[9]; const float* w_mix = (const float*)d_in[10]; const float* ln1g = (const float*)d_in[11]; const float* ln1b = (const float*)d_in[12];
    const float* w_mq = (const float*)d_in[13]; const float* w_mkv = (const float*)d_in[14]; const float* w_mo = (const float*)d_in[15];
    const float* ln2g = (const float*)d_in[16]; const float* ln2b = (const float*)d_in[17]; const float* w_r = (const float*)d_in[18]; const float* b_r = (const float*)d_in[19];
    const float* w_g = (const float*)d_in[20]; const float* b_g = (const float*)d_in[21]; const float* w_u = (const float*)d_in[22]; const float* b_u = (const float*)d_in[23];
    const float* w_d = (const float*)d_in[24]; const float* b_d = (const float*)d_in[25]; const float* ln3g = (const float*)d_in[26]; const float* ln3b = (const float*)d_in[27];
    float* out = (float*)d_out;
    char* ws = (char*)d_ws;
    float* Hb = (float*)(ws + 0);
    float* QA = (float*)(ws + 144 * MiB);
    float* KA = (float*)(ws + 176 * MiB);
    float* QB = (float*)(ws + 184 * MiB);
    float* KB = (float*)(ws + 216 * MiB);
    float* OT = (float*)(ws + 248 * MiB);
    float* AO = (float*)(ws + 312 * MiB);
    float* X1 = (float*)(ws + 376 * MiB);
    float* KV = (float*)(ws + 440 * MiB);
    int* cnt = (int*)(ws + 456 * MiB);
    int* off = cnt + 64;
    float* logits = (float*)(ws + 457 * MiB);
    int* list = (int*)(ws + 459 * MiB);
    float* glist = (float*)(ws + 461 * MiB);
    float* QM = (float*)(ws + 0);
    float* S = (float*)(ws + 64 * MiB);
    float* XO = (float*)(ws + 128 * MiB);
    float* X2 = (float*)(ws + 256 * MiB);
    float* HH = (float*)(ws + 0);
    float* Y = (float*)(ws + 376 * MiB);

    hipMemsetAsync(cnt, 0, 1024, stream);
    auto gemm0 = [&](int mode, GemmArgs g, dim3 grid) {
        switch (mode) {
            case 0: hipLaunchKernelGGL(k_gemm<0>, grid, dim3(256), 0, stream, g); break;
            case 1: hipLaunchKernelGGL(k_gemm<1>, grid, dim3(256), 0, stream, g); break;
            case 2: hipLaunchKernelGGL(k_gemm<2>, grid, dim3(256), 0, stream, g); break;
            case 3: hipLaunchKernelGGL(k_gemm<3>, grid, dim3(256), 0, stream, g); break;
            default: hipLaunchKernelGGL(k_gemm<4>, grid, dim3(256), 0, stream, g); break;
        }
    };
    { GemmArgs g{}; g.A = x; g.B = w_in; g.C = Hb; g.M = NTOK; g.N = DIN; g.K = DM; g.lda = DM; g.ldb = DIN; g.ldc = DIN; g.nz2 = 1; gemm0(0, g, dim3(DIN / 64, NTOK / 64, 1)); }
    { GemmArgs g{}; g.A = mem; g.B = w_mkv; g.C = KV; g.M = NB * MEMT; g.N = 2048; g.K = DM; g.lda = DM; g.ldb = 2048; g.ldc = 2048; g.nz2 = 1; gemm0(0, g, dim3(2048 / 64, NB * MEMT / 64, 1)); }
    hipLaunchKernelGGL(k_norm_rope, dim3((NTOK * 26 + 3) / 4), dim3(256), 0, stream, Hb, a_q_norm, a_k_norm, QA, KA, QB, KB);
    hipLaunchKernelGGL(k_attn<64>, dim3(SEQ / 64, 8, NB), dim3(64), 0, stream, QA, 512, KA, 128, 4, Hb + 640, DIN, 4, 64, AO, 0, 0.125f);
    hipLaunchKernelGGL(k_attn<128>, dim3(SEQ / 64, 8, NB), dim3(64), 0, stream, QB, 512, KB, 512, 1, Hb + 1792, DIN, 2, 128, OT, 1, 0.125f);
    hipLaunchKernelGGL(k_diff_combine, dim3(NTOK), dim3(256), 0, stream, OT, lq1, lk1, lq2, lk2, subln, AO);
    { GemmArgs g{}; g.A = AO; g.B = w_mix; g.C = X1; g.R = x; g.alpha = ALPHA; g.M = NTOK; g.N = DM; g.K = DM; g.lda = DM; g.ldb = DM; g.ldc = DM; g.nz2 = 1; gemm0(1, g, dim3(DM / 64, NTOK / 64, 1)); }
    hipLaunchKernelGGL(k_ln, dim3(NTOK / 4), dim3(256), 0, stream, X1, ln1g, ln1b, X1, (float*)nullptr, 0.f, NTOK);
    { GemmArgs g{}; g.A = X1; g.B = w_mq; g.C = QM; g.M = NTOK; g.N = DM; g.K = DM; g.lda = DM; g.ldb = DM; g.ldc = DM; g.nz2 = 1; gemm0(0, g, dim3(DM / 64, NTOK / 64, 1)); }
    { GemmArgs g{}; g.A = QM; g.B = KV; g.C = S; g.alpha = 0.0625f; g.M = SEQ; g.N = 256; g.K = 256; g.lda = DM; g.ldb = 2048; g.ldc = DM; g.transB = 1; g.nz2 = 4;
      g.a1 = (long)SEQ * DM; g.a2 = 256; g.b1 = (long)MEMT * 2048; g.b2 = 256; g.c1 = (long)SEQ * DM; g.c2 = 256; gemm0(4, g, dim3(4, SEQ / 64, NB * 4)); }
    hipLaunchKernelGGL(k_softmax256, dim3(NTOK * 4 / 4), dim3(256), 0, stream, S, (long)NTOK * 4);
    { GemmArgs g{}; g.A = S; g.B = KV + 1024; g.C = XO; g.M = SEQ; g.N = 256; g.K = 256; g.lda = DM; g.ldb = 2048; g.ldc = DM; g.nz2 = 4;
      g.a1 = (long)SEQ * DM; g.a2 = 256; g.b1 = (long)MEMT * 2048; g.b2 = 256; g.c1 = (long)SEQ * DM; g.c2 = 256; gemm0(0, g, dim3(4, SEQ / 64, NB * 4)); }
    { GemmArgs g{}; g.A = XO; g.B = w_mo; g.C = X2; g.R = X1; g.alpha = ALPHA; g.M = NTOK; g.N = DM; g.K = DM; g.lda = DM; g.ldb = DM; g.ldc = DM; g.nz2 = 1; gemm0(1, g, dim3(DM / 64, NTOK / 64, 1)); }
    hipLaunchKernelGGL(k_ln, dim3(NTOK / 4), dim3(256), 0, stream, X2, ln2g, ln2b, X2, Y, ALPHA, NTOK);
    { GemmArgs g{}; g.A = X2; g.B = w_r; g.C = logits; g.bias = b_r; g.M = NTOK; g.N = NE; g.K = DM; g.lda = DM; g.ldb = NE; g.ldc = NE; g.nz2 = 1; gemm0(0, g, dim3(1, NTOK / 64, 1)); }
    hipLaunchKernelGGL(k_topk, dim3(NTOK / 256), dim3(256), 0, stream, logits, cnt, list, glist);
    hipLaunchKernelGGL(k_offsets, dim3(1), dim3(64), 0, stream, cnt, off);
    { GemmArgs g{}; g.A = X2; g.B = w_g; g.B2 = w_u; g.C = HH; g.bias = b_g; g.bias2 = b_u; g.rowidx = list; g.Mdev = cnt; g.offdev = off; g.coff_dev = 1;
      g.M = NTOK; g.N = DM; g.K = DM; g.lda = DM; g.ldb = DM; g.ldc = DM; g.nz2 = 1; g.b1 = (long)DM * DM; g.bias1 = DM; g.idx1 = CAP; gemm0(2, g, dim3(DM / 64, NTOK / 64, NE)); }
    { GemmArgs g{}; g.A = HH; g.B = w_d; g.C = Y; g.bias = b_d; g.rowidx = list; g.Mdev = cnt; g.offdev = off; g.aoff_dev = 1; g.gate = glist;
      g.M = NTOK; g.N = DM; g.K = DM; g.lda = DM; g.ldb = DM; g.ldc = DM; g.nz2 = 1; g.b1 = (long)DM * DM; g.bias1 = DM; g.idx1 = CAP; gemm0(3, g, dim3(DM / 64, NTOK / 64, NE)); }
    hipLaunchKernelGGL(k_ln, dim3(NTOK / 4), dim3(256), 0, stream, Y, ln3g, ln3b, out, (float*)nullptr, 0.f, NTOK);
}
```

```cpp
#include <hip/hip_runtime.h>
#include <cstdio>
#include <cstdint>
namespace pg8 {
#define PG8_LAS __attribute__((address_space(3)))
typedef unsigned short bf16_t;
typedef short bf16x8 __attribute__((ext_vector_type(8)));
typedef float f32x4 __attribute__((ext_vector_type(4)));
typedef unsigned u32x4 __attribute__((ext_vector_type(4)));
constexpr int BM = 256, BK = 64, HALF = 128, HTB = HALF * BK * 2  , STAGE_BYTES = 8 * HTB, NXCD = 8, WGM = 8;

__host__ __device__ __forceinline__ int lds_byte(int r, int c) { const int st = (r >> 4) * 2 + (c >> 5), rr = r & 15, cc = c & 31, ob = rr * 64 + cc * 2; return st * 1024 + (ob ^ (((ob >> 9) & 1) << 5)); }
__host__ __device__ __forceinline__ void stage_rc(int b, int& R, int& C) { const int st = b / 1024, sb = b % 1024, swz = sb ^ (((sb >> 9) & 1) << 5); R = (st >> 1) * 16 + swz / 64; C = (st & 1) * 32 + (swz % 64) / 2; }
__host__ __device__ __forceinline__ int perm32(int rho) { const int n = rho >> 4, i = rho & 15; return 8 * (i >> 2) + 4 * n + (i & 3); }
__device__ __forceinline__ unsigned cvt_pk_bf16(float lo, float hi) { unsigned r; asm volatile("v_cvt_pk_bf16_f32 %0, %1, %2" : "=v"(r) : "v"(lo), "v"(hi)); return r; }
typedef float f32x2 __attribute__((ext_vector_type(2)));

struct Unit { const char* A; const char* B; void* O; int ldo, orow, ocol, aux, gidx; };
struct Gemm { int lda, ldb, K; };

struct EpiBf16 {
    static constexpr bool PERM = true, AFTER_DRAIN = false;
    bf16_t* O; int ldc; const float* bias; int bstride; float scale;
    __device__ __forceinline__ void operator()(const f32x4 (&acc)[2][2][4][2], const Unit& u, int wr, int wc, int fr, int fq) const {
        bf16_t* base = O ? O : (bf16_t*)u.O; const int ld = O ? ldc : u.ldo;
        const int row0 = u.orow + wr * 64 + fr, col0 = u.ocol + wc * 32 + 8 * fq;
        f32x4 bv[2][2];
#pragma unroll
        for (int bj = 0; bj < 2; ++bj)
#pragma unroll
            for (int n = 0; n < 2; ++n) bv[bj][n] = bias ? *(const f32x4*)(bias + (size_t)u.aux * bstride + col0 + bj * HALF + 4 * n) : (f32x4){0.f, 0.f, 0.f, 0.f};
#pragma unroll
        for (int ai = 0; ai < 2; ++ai)
#pragma unroll
            for (int m = 0; m < 4; ++m) { bf16_t* rowp = base + (size_t)(row0 + ai * HALF + m * 16) * ld + col0;
#pragma unroll
                for (int bj = 0; bj < 2; ++bj) { f32x4 v0 = (acc[ai][bj][m][0] + bv[bj][0]) * scale, v1 = (acc[ai][bj][m][1] + bv[bj][1]) * scale;
                    u32x4 w; w.x = cvt_pk_bf16(v0[0], v0[1]); w.y = cvt_pk_bf16(v0[2], v0[3]); w.z = cvt_pk_bf16(v1[0], v1[1]); w.w = cvt_pk_bf16(v1[2], v1[3]);
                    *(u32x4*)(rowp + bj * HALF) = w; } }
    }
};
struct EpiF32 {
    static constexpr bool PERM = false, AFTER_DRAIN = false;
    float* out; const float* base; int ldc; float alpha, scale;
    __device__ __forceinline__ void operator()(const f32x4 (&acc)[2][2][4][2], const Unit& u, int wr, int wc, int fr, int fq) const {
        const int col0 = u.ocol + wc * 32 + 4 * fq;
#pragma unroll
        for (int ai = 0; ai < 2; ++ai)
#pragma unroll
            for (int m = 0; m < 4; ++m) { const size_t off = (size_t)(u.orow + ai * HALF + wr * 64 + m * 16 + fr) * ldc + col0;
#pragma unroll
                for (int bj = 0; bj < 2; ++bj)
#pragma unroll
                    for (int n = 0; n < 2; ++n) { f32x4 o = acc[ai][bj][m][n] * scale;
                        if (base) { const f32x4 bs = *(const f32x4*)(base + off + bj * HALF + n * 16); o = o + bs * alpha; }
                        *(f32x4*)(out + off + bj * HALF + n * 16) = o; }
                if (m & 1) asm volatile("" ::: "memory"); }
    }
};
struct EpiSwiglu {
    static constexpr bool PERM = true, AFTER_DRAIN = false;
    bf16_t* H; int ldc; const float* bg; const float* bu;
    __device__ __forceinline__ static float act(float g, float u) {
        g = fminf(g, 7.0f); u = fminf(fmaxf(u, -7.0f), 7.0f);
        const float sg = __builtin_amdgcn_rcpf(1.0f + __builtin_amdgcn_exp2f(-1.702f * 1.4426950408889634f * g));
        return g * sg * (u + 1.0f);
    }
    __device__ __forceinline__ void operator()(const f32x4 (&acc)[2][2][4][2], const Unit& u, int wr, int wc, int fr, int fq) const {
        const int row0 = u.orow + wr * 64 + fr, col0 = u.ocol + wc * 32 + 8 * fq;
        f32x4 bgv[2], buv[2];
#pragma unroll
        for (int n = 0; n < 2; ++n) { bgv[n] = *(const f32x4*)(bg + (size_t)u.aux * 1024 + col0 + 4 * n); buv[n] = *(const f32x4*)(bu + (size_t)u.aux * 1024 + col0 + 4 * n); }
#pragma unroll
        for (int ai = 0; ai < 2; ++ai)
#pragma unroll
            for (int m = 0; m < 4; ++m) { bf16_t* rowp = H + (size_t)(row0 + ai * HALF + m * 16) * ldc + col0;
                const f32x4 g0 = acc[ai][0][m][0] + bgv[0], g1 = acc[ai][0][m][1] + bgv[1], u0 = acc[ai][1][m][0] + buv[0], u1 = acc[ai][1][m][1] + buv[1];
                u32x4 w; w.x = cvt_pk_bf16(act(g0[0], u0[0]), act(g0[1], u0[1])); w.y = cvt_pk_bf16(act(g0[2], u0[2]), act(g0[3], u0[3]));
                w.z = cvt_pk_bf16(act(g1[0], u1[0]), act(g1[1], u1[1])); w.w = cvt_pk_bf16(act(g1[2], u1[2]), act(g1[3], u1[3]));
                *(u32x4*)rowp = w; }
    }
};

template <class Epi, class Sched, bool ALIGN_EPI, bool GATHER>
__device__ __forceinline__ void gemm_phase(PG8_LAS unsigned char* lds, PG8_LAS unsigned char* ldsall, const Gemm g, const Sched& S, const Epi& E) {
    const int tid = threadIdx.x, wid = __builtin_amdgcn_readfirstlane(tid >> 6), lane = tid & 63, wr = wid >> 2, wc = wid & 3, fr = lane & 15, fq = lane >> 4;
    const int K = g.K, nt = K / BK;
    unsigned voffA[2], voffB[2]; int Rr[2], Cb[2];
#pragma unroll
    for (int i = 0; i < 2; ++i) { int R, C; stage_rc(tid * 16 + i * 8192, R, C); const int Rb = Epi::PERM ? ((R & ~31) + perm32(R & 31)) : R;
        voffA[i] = (unsigned)(R * g.lda + C) * 2u; voffB[i] = (unsigned)(Rb * g.ldb + C) * 2u; Rr[i] = R; Cb[i] = C * 2; }
    const size_t kstep = (size_t)(BK * 2);
    const size_t hstepA = (size_t)HALF * g.lda * 2, hstepB = (size_t)HALF * g.ldb * 2;
    const unsigned ldsw = (unsigned)wid * 1024u;
    const int aoff = lds_byte(wr * 64 + fr, fq * 8), boff = lds_byte(wc * 32 + fr, fq * 8);
    const unsigned lda2 = (unsigned)g.lda * 2u;
#define PG8_SA(b, h) (((b) * 2 + (h)) * HTB)
#define PG8_SB(b, h) ((4 + (b) * 2 + (h)) * HTB)
#define PG8_GL(bufoff, ptr, i_) __builtin_amdgcn_global_load_lds((const unsigned*)(ptr), (PG8_LAS unsigned*)(lds + (bufoff) + ldsw + (i_) * 8192), 16, 0, 0)
#define PG8_STAGE_B(bufoff, gbase) do { _Pragma("unroll") for (int _i = 0; _i < 2; ++_i) PG8_GL(bufoff, (const char*)(gbase) + voffB[_i], _i); } while (0)
#define PG8_STAGE_A(bufoff, gbase, h, OFFS) do { _Pragma("unroll") for (int _i = 0; _i < 2; ++_i) { \
        if constexpr (GATHER) PG8_GL(bufoff, (const char*)(gbase) + OFFS[h][_i], _i); else PG8_GL(bufoff, (const char*)(gbase) + (h) * hstepA + voffA[_i], _i); } } while (0)
#define PG8_LDA(dst, b, h) do { _Pragma("unroll") for (int m = 0; m < 4; ++m) _Pragma("unroll") for (int k = 0; k < 2; ++k) dst[m][k] = *(const PG8_LAS bf16x8*)(lds + PG8_SA(b, h) + aoff + m * 2048 + k * 1024); } while (0)
#define PG8_LDB(dst, b, h) do { _Pragma("unroll") for (int n = 0; n < 2; ++n) _Pragma("unroll") for (int k = 0; k < 2; ++k) dst[n][k] = *(const PG8_LAS bf16x8*)(lds + PG8_SB(b, h) + boff + n * 2048 + k * 1024); } while (0)
#define PG8_MMA(ai, bj, At, Bt) do { __builtin_amdgcn_s_setprio(1); _Pragma("unroll") for (int m = 0; m < 4; ++m) _Pragma("unroll") for (int n = 0; n < 2; ++n) _Pragma("unroll") for (int k = 0; k < 2; ++k) \
        acc[ai][bj][m][n] = __builtin_amdgcn_mfma_f32_16x16x32_bf16(Bt[n][k], At[m][k], acc[ai][bj][m][n], 0, 0, 0); __builtin_amdgcn_s_setprio(0); } while (0)
#define PG8_WAIT_V(n) asm volatile("s_waitcnt vmcnt(" #n ")" ::: "memory")
#define PG8_WAIT_L(n) asm volatile("s_waitcnt lgkmcnt(" #n ")" ::: "memory")
#define PG8_BAR __builtin_amdgcn_s_barrier()
#define PG8_SCHED __builtin_amdgcn_sched_barrier(0)
#define PG8_GIDX(dst, un) do { if constexpr (GATHER) { const PG8_LAS int* _ix = (const PG8_LAS int*)(ldsall + (un).gidx); _Pragma("unroll") for (int _h = 0; _h < 2; ++_h) _Pragma("unroll") for (int _i = 0; _i < 2; ++_i) \
        dst[_h][_i] = (unsigned)_ix[_h * HALF + Rr[_i]] * lda2 + (unsigned)Cb[_i]; } } while (0)
    Unit cur, nxt; int ui = 0;
    if (!S.next(0, cur)) return;
    f32x4 acc[2][2][4][2];
#pragma unroll
    for (int a = 0; a < 2; ++a)
#pragma unroll
        for (int b = 0; b < 2; ++b)
#pragma unroll
            for (int m = 0; m < 4; ++m)
#pragma unroll
                for (int n = 0; n < 2; ++n) acc[a][b][m][n] = (f32x4){0.f, 0.f, 0.f, 0.f};
    bf16x8 At[4][2], B0[2][2], B1[2][2];
    unsigned gA[2][2] = {{0u, 0u}, {0u, 0u}}, gN[2][2] = {{0u, 0u}, {0u, 0u}};
    PG8_GIDX(gA, cur);
    const char* cA = cur.A; const char* cB = cur.B;
    PG8_STAGE_B(PG8_SB(0, 0), cB); PG8_STAGE_B(PG8_SB(0, 1), cB + hstepB); PG8_STAGE_A(PG8_SA(0, 0), cA, 0, gA); PG8_STAGE_A(PG8_SA(0, 1), cA, 1, gA);
    if (wr == 1) PG8_BAR;
    PG8_WAIT_V(2); PG8_BAR;
    PG8_STAGE_B(PG8_SB(1, 0), cB + kstep); PG8_STAGE_A(PG8_SA(1, 0), cA + kstep, 0, gA); PG8_STAGE_B(PG8_SB(1, 1), cB + hstepB + kstep);
    PG8_WAIT_V(6); PG8_BAR;
    for (;;) {
        const bool has_next = S.next(ui + 1, nxt);
        const char* nA = has_next ? nxt.A : cA; const char* nB = has_next ? nxt.B : cB;
        if constexpr (GATHER) { if (has_next) { PG8_GIDX(gN, nxt); } else {
#pragma unroll
            for (int h = 0; h < 2; ++h)
#pragma unroll
                for (int i = 0; i < 2; ++i) gN[h][i] = gA[h][i]; } }
        for (int t = 0; t < nt; t += 2) {
            const bool last = (t == nt - 2);
            const char* a1 = cA + (size_t)(t + 1) * kstep;
            const char* a2 = last ? nA : cA + (size_t)(t + 2) * kstep; const char* b2 = last ? nB : cB + (size_t)(t + 2) * kstep;
            const char* a3 = a2 + kstep; const char* b3 = b2 + kstep;
            unsigned g2[2][2];
#pragma unroll
            for (int h = 0; h < 2; ++h)
#pragma unroll
                for (int i = 0; i < 2; ++i) g2[h][i] = last ? gN[h][i] : gA[h][i];
            PG8_LDB(B0, 0, 0); PG8_LDB(B1, 0, 1); PG8_SCHED; PG8_LDA(At, 0, 0); PG8_STAGE_A(PG8_SA(1, 1), a1, 1, gA);
            PG8_WAIT_V(8); PG8_WAIT_L(0); PG8_BAR; PG8_MMA(0, 0, At, B0); PG8_MMA(0, 1, At, B1); PG8_BAR; PG8_SCHED;
            PG8_LDA(At, 0, 1); PG8_STAGE_B(PG8_SB(0, 0), b2); PG8_STAGE_B(PG8_SB(0, 1), b2 + hstepB); PG8_STAGE_A(PG8_SA(0, 0), a2, 0, g2);
            PG8_WAIT_V(8); PG8_WAIT_L(0); PG8_BAR; PG8_MMA(1, 0, At, B0); PG8_MMA(1, 1, At, B1); PG8_BAR; PG8_SCHED;
            PG8_LDB(B0, 1, 0); PG8_LDB(B1, 1, 1); PG8_SCHED; PG8_LDA(At, 1, 0); PG8_STAGE_A(PG8_SA(0, 1), a2, 1, g2);
            PG8_WAIT_V(8); PG8_WAIT_L(0); PG8_BAR; PG8_MMA(0, 0, At, B0); PG8_MMA(0, 1, At, B1); PG8_BAR; PG8_SCHED;
            PG8_LDA(At, 1, 1); PG8_STAGE_B(PG8_SB(1, 0), b3); PG8_STAGE_B(PG8_SB(1, 1), b3 + hstepB); PG8_STAGE_A(PG8_SA(1, 0), a3, 0, g2);
            PG8_WAIT_V(8); PG8_WAIT_L(0); PG8_BAR; PG8_MMA(1, 0, At, B0); PG8_MMA(1, 1, At, B1); PG8_BAR; PG8_SCHED;
        }
        if constexpr (ALIGN_EPI) { if (wr == 0) PG8_BAR; }
        if constexpr (!Epi::AFTER_DRAIN) { E(acc, cur, wr, wc, fr, fq); }
        if (!has_next) break;
#pragma unroll
        for (int a = 0; a < 2; ++a)
#pragma unroll
            for (int b = 0; b < 2; ++b)
#pragma unroll
                for (int m = 0; m < 4; ++m)
#pragma unroll
                    for (int n = 0; n < 2; ++n) acc[a][b][m][n] = (f32x4){0.f, 0.f, 0.f, 0.f};
        cur = nxt; cA = nA; cB = nB; ++ui;
#pragma unroll
        for (int h = 0; h < 2; ++h)
#pragma unroll
            for (int i = 0; i < 2; ++i) gA[h][i] = gN[h][i];
        if constexpr (ALIGN_EPI) { if (wr == 1) PG8_BAR; }
    }
    PG8_WAIT_V(0);
    if constexpr (!ALIGN_EPI) { if (wr == 0) PG8_BAR; }
    PG8_BAR;
    if constexpr (Epi::AFTER_DRAIN) { E.fused(acc, cur, wr, wc, fr, fq, lds, wid, lane); }
#undef PG8_SA
#undef PG8_SB
#undef PG8_GL
#undef PG8_STAGE_A
#undef PG8_STAGE_B
#undef PG8_LDA
#undef PG8_LDB
#undef PG8_MMA
#undef PG8_WAIT_V
#undef PG8_WAIT_L
#undef PG8_BAR
#undef PG8_SCHED
#undef PG8_GIDX
}
}
#include <hip/hip_bf16.h>
#include <cmath>
namespace attn_body {
using bf16=__hip_bfloat16;
using bf16x8=__attribute__((ext_vector_type(8)))short;
using s16x4=__attribute__((ext_vector_type(4)))short;
using f32x16=__attribute__((ext_vector_type(16)))float;
using u32x4=__attribute__((ext_vector_type(4)))unsigned;
constexpr int SEQ=2048,D=64;
constexpr int NW=8,QBLK=32,QB=QBLK*NW,KVBLK=64,NQB=SEQ/QB;
constexpr int ATTN_UNIT_ROWS=QB;
struct AttnPtrs { const __hip_bfloat16* Q; const __hip_bfloat16* K; const __hip_bfloat16* V; __hip_bfloat16* O; int ldq, ldk, ldv, ldo; };
__device__ __forceinline__ int crow(int r,int hi){return (r&3)+8*(r>>2)+4*hi;}
#define SBAR() __builtin_amdgcn_sched_barrier(0)
__device__ __forceinline__ void cmask(f32x16&p0,f32x16&p1,int jb,int qrel,int hi){
  const float NEG=-INFINITY; int kb=64*jb+4*hi;
  #pragma unroll
  for(int r=0;r<16;++r){int kv=kb+(r&3)+8*(r>>2); if(kv>qrel)p0[r]=NEG; if(kv+32>qrel)p1[r]=NEG;}
}

constexpr int NSLOT=3, SLOTB=8192;
constexpr int LDS_K=0, LDS_V=NSLOT*SLOTB, LDS_WS=2*NSLOT*SLOTB, LDS_OST=LDS_WS+NW*64*4, LDS_BYTES=LDS_OST+NW*4096;
constexpr float C2=0.125f*1.4426950408889634f;
__device__ __forceinline__ void glds16(const void*gsrc,unsigned lds_dst){unsigned keep;
  asm volatile("s_mov_b32 %0, m0\n\ts_mov_b32 m0, %2\n\ts_nop 0\n\tglobal_load_lds_dwordx4 %1, off\n\ts_mov_b32 m0, %0":"=&s"(keep):"v"(gsrc),"s"(lds_dst):"memory");}
__device__ __forceinline__ float max3f(float a,float b,float c){float r;asm("v_max3_f32 %0, %1, %2, %3":"=v"(r):"v"(a),"v"(b),"v"(c));return r;}
__device__ __forceinline__ float max2f(float a,float b){float r;asm("v_max_f32_e32 %0, %1, %2":"=v"(r):"v"(a),"v"(b));return r;}
__device__ __forceinline__ float fadd_s(float a,float b){float r;asm("v_add_f32_e32 %0, %1, %2":"=v"(r):"v"(a),"v"(b));return r;}
__device__ __forceinline__ float fsub_s(float a,float b){float r;asm("v_sub_f32_e32 %0, %1, %2":"=v"(r):"v"(a),"v"(b));return r;}
typedef float f32x2_t __attribute__((ext_vector_type(2))); typedef __bf16 bf16x2_t __attribute__((ext_vector_type(2)));
__device__ __forceinline__ unsigned cvtpk_s(float lo,float hi){f32x2_t v={lo,hi};bf16x2_t b=__builtin_convertvector(v,bf16x2_t);return __builtin_bit_cast(unsigned,b);}
#define WAIT_BAR(N) asm volatile("s_waitcnt vmcnt(" #N ") lgkmcnt(0)\n\ts_barrier":::"memory")

__device__ __forceinline__ void qkt(f32x16&p0,f32x16&p1,const char*Kslot,const bf16x8*qr,const f32x16&negm,int r32,int hi){
  const char*kb=Kslot+hi*1024+r32*16;
  #pragma unroll
  for(int d0=0;d0<4;++d0){
    const bf16x8 b0=*reinterpret_cast<const bf16x8*>(kb+d0*2048);
    const bf16x8 b1=*reinterpret_cast<const bf16x8*>(kb+d0*2048+512);
    if(d0==0){p0=__builtin_amdgcn_mfma_f32_32x32x16_bf16(b0,qr[0],negm,0,0,0);p1=__builtin_amdgcn_mfma_f32_32x32x16_bf16(b1,qr[0],negm,0,0,0);}
    else{p0=__builtin_amdgcn_mfma_f32_32x32x16_bf16(b0,qr[d0],p0,0,0,0);p1=__builtin_amdgcn_mfma_f32_32x32x16_bf16(b1,qr[d0],p1,0,0,0);}}
}
typedef __attribute__((address_space(3))) const char* lds_cptr;
typedef short v4i16_t __attribute__((ext_vector_type(4)));
__device__ __forceinline__ void kload8(bf16x8*kf,lds_cptr kp){
  kf[0]=*(const __attribute__((address_space(3))) bf16x8*)(kp);      kf[1]=*(const __attribute__((address_space(3))) bf16x8*)(kp+512);
  kf[2]=*(const __attribute__((address_space(3))) bf16x8*)(kp+2048); kf[3]=*(const __attribute__((address_space(3))) bf16x8*)(kp+2560);
  kf[4]=*(const __attribute__((address_space(3))) bf16x8*)(kp+4096); kf[5]=*(const __attribute__((address_space(3))) bf16x8*)(kp+4608);
  kf[6]=*(const __attribute__((address_space(3))) bf16x8*)(kp+6144); kf[7]=*(const __attribute__((address_space(3))) bf16x8*)(kp+6656);
}
__device__ __forceinline__ void kload2(bf16x8*kf,lds_cptr kp,int j){ kf[2*j]=*(const __attribute__((address_space(3))) bf16x8*)(kp+j*2048); kf[2*j+1]=*(const __attribute__((address_space(3))) bf16x8*)(kp+j*2048+512); }
__device__ __forceinline__ s16x4 vtr(lds_cptr p){ return __builtin_bit_cast(s16x4,__builtin_amdgcn_ds_read_tr16_b64_v4i16((__attribute__((address_space(3))) v4i16_t*)p)); }
__device__ __forceinline__ float rowmax(const f32x16&p0,const f32x16&p1){
  float a=max3f(p0[0],p0[1],p1[0]),b=max3f(p0[2],p0[3],p1[1]);a=max3f(a,p1[2],p1[3]);
  #pragma unroll
  for(int r=4;r<16;r+=4){a=max3f(a,p0[r],p0[r+1]);b=max3f(b,p0[r+2],p0[r+3]);a=max3f(a,p1[r],p1[r+1]);b=max3f(b,p1[r+2],p1[r+3]);}
  const float m=max2f(a,b);
  auto rr=__builtin_amdgcn_permlane32_swap(__float_as_uint(m),__float_as_uint(m),false,false);
  return max2f(__uint_as_float(rr[0]),__uint_as_float(rr[1]));
}
__device__ __forceinline__ void pv(f32x16*o,int vb,bf16x8 pa0,bf16x8 pa1,bf16x8 pa2,bf16x8 pa3){
  #pragma unroll
  for(int d0=0;d0<2;++d0){s16x4 lo[4],hi[4];
    #pragma unroll
    for(int ks=0;ks<4;++ks){
      asm volatile("ds_read_b64_tr_b16 %0,%1 offset:%c2":"=&v"(lo[ks]):"v"(vb),"i"(d0*4096+ks*1024):"memory");
      asm volatile("ds_read_b64_tr_b16 %0,%1 offset:%c2":"=&v"(hi[ks]):"v"(vb),"i"(d0*4096+ks*1024+512):"memory");}
    asm volatile("s_waitcnt lgkmcnt(0)":::"memory");SBAR();
    #define PK(k) (bf16x8){lo[k][0],lo[k][1],lo[k][2],lo[k][3],hi[k][0],hi[k][1],hi[k][2],hi[k][3]}
    o[d0]=__builtin_amdgcn_mfma_f32_32x32x16_bf16(pa0,PK(0),o[d0],0,0,0);
    o[d0]=__builtin_amdgcn_mfma_f32_32x32x16_bf16(pa1,PK(1),o[d0],0,0,0);
    o[d0]=__builtin_amdgcn_mfma_f32_32x32x16_bf16(pa2,PK(2),o[d0],0,0,0);
    o[d0]=__builtin_amdgcn_mfma_f32_32x32x16_bf16(pa3,PK(3),o[d0],0,0,0);
    #undef PK
  }
}

#ifndef ATTN_STORE16
#define ATTN_STORE16(p,v) (*(u32x4*)(p)=(v))
#endif
template<int THRL> __device__ __forceinline__ void attn_unit(int qb,const AttnPtrs&P,char*shm){
  const int tid=threadIdx.x,lane=tid&63,r32=lane&31,hi=lane>>5; const int wid=__builtin_amdgcn_readfirstlane(tid>>6);
  const int q0=qb*QB; const long ldq=P.ldq,ldk=P.ldk,ldv=P.ldv,ldo=P.ldo;
  const bf16*Qw=P.Q+(long)(q0+wid*QBLK)*ldq;
  const bf16*Kh=P.K,*Vh=P.V;
  const unsigned lds0=(unsigned)(uintptr_t)shm;
  float*wsf=(float*)(shm+LDS_WS)+wid*64;
  const bf16*ksrc=Kh+(long)lane*ldk+wid*8;
  const bf16*vsrc=Vh+(long)(16*(wid&3)+(lane>>2))*ldv+(wid>>2)*32+(lane&3)*8;
  const unsigned kdst=lds0+LDS_K+wid*1024, vdst=lds0+LDS_V+wid*1024;
  #define DMA_K(t,slot) glds16(ksrc+(long)(t)*KVBLK*ldk,(unsigned)__builtin_amdgcn_readfirstlane(kdst+(slot)))
  #define DMA_V(t,slot) glds16(vsrc+(long)(t)*KVBLK*ldv,(unsigned)__builtin_amdgcn_readfirstlane(vdst+(slot)))
  const int vb0=(int)(lds0+LDS_V)+((lane>>4)&1)*32+(lane&3)*8+(4*hi+((lane&15)>>2))*64;
  const char*Kbase=shm+LDS_K; bf16x8 kf[8];
  const lds_cptr shm3=(lds_cptr)shm; const lds_cptr kp0=shm3+LDS_K+hi*1024+r32*16; const lds_cptr vp0=shm3+LDS_V+((lane>>4)&1)*32+(lane&3)*8+(4*hi+((lane&15)>>2))*64;
  constexpr int NT=SEQ/KVBLK;
  DMA_K(0,0);DMA_V(0,0);DMA_K(1,SLOTB);
  bf16x8 qr[4];
  #pragma unroll
  for(int d0=0;d0<4;++d0)qr[d0]=*reinterpret_cast<const bf16x8*>(&Qw[(long)r32*ldq+d0*16+hi*8]);
  float mhat=0.f,l_reg=0.f;f32x16 o[2];o[0]=f32x16{};o[1]=f32x16{};f32x16 negm=f32x16{};asm volatile("":"+v"(negm));
  #define CMASK(P0,P1,t) do{}while(0)
  bool resc=false;
  #define START(P0,P1) do{ const float rm=rowmax(P0,P1); resc=false; \
    { const float dl=rm; mhat=fadd_s(mhat,dl); \
      _Pragma("unroll") for(int r=0;r<16;++r){P0[r]=fsub_s(P0[r],dl);P1[r]=fsub_s(P1[r],dl);} \
      _Pragma("unroll") for(int r=0;r<16;++r)negm[r]=-mhat; asm volatile("":"+v"(negm)); } \
    _Pragma("unroll") for(int r=0;r<16;++r)P0[r]=__builtin_amdgcn_exp2f(P0[r]); }while(0)
  #define RESC() do{ if(resc){ asm volatile("s_waitcnt lgkmcnt(0)":::"memory"); \
      _Pragma("unroll") for(int d_=0;d_<2;++d_) _Pragma("unroll") for(int r=0;r<16;++r)o[d_][r]*=wsf[crow(r,hi)]; } }while(0)
  f32x16 pA0,pA1,pB0,pB1;
  int sl_prev=0,sl_cur=0,sl_next=SLOTB;
  #define ROT() do{sl_prev=sl_cur;sl_cur=sl_next;sl_next=(sl_next==(NSLOT-1)*SLOTB)?0:sl_next+SLOTB;}while(0)
  DMA_K(2,2*SLOTB);
  WAIT_BAR(3);
  qkt(pA0,pA1,Kbase,qr,negm,r32,hi);asm volatile("s_nop 15\n\ts_nop 7":"+v"(pA0),"+v"(pA1));CMASK(pA0,pA1,0);
  START(pA0,pA1);
  _Pragma("unroll") for(int r=0;r<16;++r)pA1[r]=__builtin_amdgcn_exp2f(pA1[r]);
  WAIT_BAR(0);
  DMA_K(3,0);DMA_V(1,SLOTB);
  ROT();
  kload8(kf,kp0+sl_cur);
  WAIT_BAR(2);
  s16x4 vlo[8],vhi[8]; u32x4 pw0,pw1,pw2,pw3;
  #define PKW(P,B) cvtpk_s(P[B],P[B+1])
  #define PAF(k) __builtin_bit_cast(bf16x8,pw##k)
  #define VFR(i) (bf16x8){vlo[i][0],vlo[i][1],vlo[i][2],vlo[i][3],vhi[i][0],vhi[i][1],vhi[i][2],vhi[i][3]}
  #define PIN(x) asm volatile("":"+v"(x))
  #define MX3(a,b,c) __builtin_fmaxf(__builtin_fmaxf((a),(b)),(c))
  #define GAPA(MF,A0,A1,A2,A3,W0,W1,PW) do{ MF; sacc+=A0; sacc+=A1; sacc+=A2; sacc+=A3; PIN(sacc); W0; W1; PIN(PW); SBAR(); }while(0)
  #define EX(v) __builtin_amdgcn_exp2f(v)
  #define GAPB(MF,X,B) do{ MF; X[B]=EX(X[B]); X[B+1]=EX(X[B+1]); X[B+2]=EX(X[B+2]); X[B+3]=EX(X[B+3]); PIN(X); SBAR(); }while(0)
  #define VRD(i) do{ vlo[i]=vtr(vp_+(((i)>>2)*4096+((i)&3)*1024)); vhi[i]=vtr(vp_+(((i)>>2)*4096+((i)&3)*1024+512)); }while(0)
  #define KRD(G,j) do{ if(G){ kload2(kf,kp0+sl_next,j); SBAR(); } }while(0)
  #define STEP(C0,C1,P0,P1,t,GK,GV,GL) do{ SBAR(); \
    const lds_cptr vp_=vp0+sl_prev; \
    VRD(0); SBAR(); float sacc=(P0[0]+P0[1]); \
    GAPA(C0=__builtin_amdgcn_mfma_f32_32x32x16_bf16(kf[0],qr[0],negm,0,0,0), P0[2],P0[3],P0[4],P0[5],     pw0[0]=PKW(P0,0), pw0[1]=PKW(P0,2), pw0); \
    VRD(4); SBAR(); GAPA(C1=__builtin_amdgcn_mfma_f32_32x32x16_bf16(kf[1],qr[0],negm,0,0,0), P0[6],P0[7],P0[8],P0[9],     pw0[2]=PKW(P0,4), pw0[3]=PKW(P0,6), pw0); \
    VRD(1); SBAR(); GAPA(C0=__builtin_amdgcn_mfma_f32_32x32x16_bf16(kf[2],qr[1],C0,0,0,0),   P0[10],P0[11],P0[12],P0[13], pw1[0]=PKW(P0,8), pw1[1]=PKW(P0,10), pw1); \
    VRD(5); SBAR(); GAPA(C1=__builtin_amdgcn_mfma_f32_32x32x16_bf16(kf[3],qr[1],C1,0,0,0),   P0[14],P0[15],P1[0],P1[1],   pw1[2]=PKW(P0,12),pw1[3]=PKW(P0,14), pw1); \
    VRD(2); SBAR(); GAPA(C0=__builtin_amdgcn_mfma_f32_32x32x16_bf16(kf[4],qr[2],C0,0,0,0),   P1[2],P1[3],P1[4],P1[5],     pw2[0]=PKW(P1,0), pw2[1]=PKW(P1,2), pw2); \
    VRD(6); SBAR(); GAPA(C1=__builtin_amdgcn_mfma_f32_32x32x16_bf16(kf[5],qr[2],C1,0,0,0),   P1[6],P1[7],P1[8],P1[9],     pw2[2]=PKW(P1,4), pw2[3]=PKW(P1,6), pw2); \
    VRD(3); SBAR(); GAPA(C0=__builtin_amdgcn_mfma_f32_32x32x16_bf16(kf[6],qr[3],C0,0,0,0),   P1[10],P1[11],P1[12],P1[13], pw3[0]=PKW(P1,8), pw3[1]=PKW(P1,10), pw3); \
    VRD(7); SBAR(); GAPA(C1=__builtin_amdgcn_mfma_f32_32x32x16_bf16(kf[7],qr[3],C1,0,0,0),   P1[14],P1[15],0.f,0.f,       pw3[2]=PKW(P1,12),pw3[3]=PKW(P1,14), pw3); \
    l_reg+=sacc; \
    if(GK){DMA_K((t)+3,sl_cur);} if(GV){DMA_V((t)+1,sl_next);} \
    CMASK(C0,C1,t); \
    { float a=MX3(C0[0],C0[1],C1[0]),b=MX3(C0[2],C0[3],C1[1]); a=MX3(a,C1[2],C1[3]); \
      _Pragma("unroll") for(int r=4;r<16;r+=4){a=MX3(a,C0[r],C0[r+1]);b=MX3(b,C0[r+2],C0[r+3]);a=MX3(a,C1[r],C1[r+1]);b=MX3(b,C1[r+2],C1[r+3]);} \
      float rm=__builtin_fmaxf(a,b); { auto rr=__builtin_amdgcn_permlane32_swap(__float_as_uint(rm),__float_as_uint(rm),false,false); rm=__builtin_fmaxf(__uint_as_float(rr[0]),__uint_as_float(rr[1])); } \
      resc=false; \
      if(__builtin_expect(__any(rm>(float)THRL),0)){ const float dl=__builtin_fmaxf(rm,0.f); mhat+=dl; \
        _Pragma("unroll") for(int r=0;r<16;++r){C0[r]-=dl;C1[r]-=dl;} \
        _Pragma("unroll") for(int r=0;r<16;++r)negm[r]=-mhat; asm volatile("":"+v"(negm)); \
        const float f=__builtin_amdgcn_exp2f(-dl); l_reg*=f; if(hi==0)wsf[r32]=f; resc=true; } } \
    SBAR(); \
    GAPB(o[0]=__builtin_amdgcn_mfma_f32_32x32x16_bf16(PAF(0),VFR(0),o[0],0,0,0), C0,0); \
    GAPB(o[1]=__builtin_amdgcn_mfma_f32_32x32x16_bf16(PAF(0),VFR(4),o[1],0,0,0), C0,4); \
    KRD(GL,0); GAPB(o[0]=__builtin_amdgcn_mfma_f32_32x32x16_bf16(PAF(1),VFR(1),o[0],0,0,0), C0,8); \
    KRD(GL,1); GAPB(o[1]=__builtin_amdgcn_mfma_f32_32x32x16_bf16(PAF(1),VFR(5),o[1],0,0,0), C0,12); \
    KRD(GL,2); GAPB(o[0]=__builtin_amdgcn_mfma_f32_32x32x16_bf16(PAF(2),VFR(2),o[0],0,0,0), C1,0); \
    KRD(GL,3); GAPB(o[1]=__builtin_amdgcn_mfma_f32_32x32x16_bf16(PAF(2),VFR(6),o[1],0,0,0), C1,4); \
    GAPB(o[0]=__builtin_amdgcn_mfma_f32_32x32x16_bf16(PAF(3),VFR(3),o[0],0,0,0), C1,8); \
    GAPB(o[1]=__builtin_amdgcn_mfma_f32_32x32x16_bf16(PAF(3),VFR(7),o[1],0,0,0), C1,12); \
    }while(0)
  int t=1;
  for(;t+5<NT;t+=2){
    STEP(pB0,pB1,pA0,pA1,t,true,true,true);     WAIT_BAR(2); RESC(); ROT();
    STEP(pA0,pA1,pB0,pB1,t+1,true,true,true);   WAIT_BAR(2); RESC(); ROT();
  }
  #define ENDW(tt) do{ if((tt)+3<NT){WAIT_BAR(2);} else if((tt)+2<NT){WAIT_BAR(1);} else {WAIT_BAR(0);} }while(0)
  for(;t+1<NT;t+=2){
    STEP(pB0,pB1,pA0,pA1,t,(t+3<NT),(t+1<NT),(t+1<NT));       ENDW(t);   RESC(); ROT();
    STEP(pA0,pA1,pB0,pB1,t+1,(t+4<NT),(t+2<NT),(t+2<NT));     ENDW(t+1); RESC(); ROT();
  }
  STEP(pB0,pB1,pA0,pA1,NT-1,false,false,false); RESC();
  { float sacc=pB0[0]+pB0[1]; _Pragma("unroll") for(int r=2;r<16;++r)sacc+=pB0[r]; _Pragma("unroll") for(int r=0;r<16;++r)sacc+=pB1[r]; l_reg+=sacc;
    pw0=(u32x4){PKW(pB0,0),PKW(pB0,2),PKW(pB0,4),PKW(pB0,6)};pw1=(u32x4){PKW(pB0,8),PKW(pB0,10),PKW(pB0,12),PKW(pB0,14)};pw2=(u32x4){PKW(pB1,0),PKW(pB1,2),PKW(pB1,4),PKW(pB1,6)};pw3=(u32x4){PKW(pB1,8),PKW(pB1,10),PKW(pB1,12),PKW(pB1,14)};
    SBAR(); pv(o,vb0+sl_cur,PAF(0),PAF(1),PAF(2),PAF(3)); }
  #undef PKW
  #undef PAF
  #undef VFR
  #undef PIN
  #undef MX3
  #undef GAPA
  #undef GAPB
  #undef EX
  #undef VRD
  #undef KRD
  #undef STEP
  #undef ENDW
  {auto rr=__builtin_amdgcn_permlane32_swap(__float_as_uint(l_reg),__float_as_uint(l_reg),false,false);l_reg=__uint_as_float(rr[0])+__uint_as_float(rr[1]);}
  if(hi==0)wsf[32+r32]=l_reg;asm volatile("s_waitcnt lgkmcnt(0)":::"memory");
  float rli[16];
  #pragma unroll
  for(int r=0;r<16;++r)rli[r]=__builtin_amdgcn_rcpf(wsf[32+crow(r,hi)]);
  bf16*Ow=P.O+(long)(q0+wid*QBLK)*ldo;
  { bf16*stg=(bf16*)(shm+LDS_OST)+wid*2048;
    #pragma unroll
    for(int r=0;r<16;++r){const int orow=crow(r,hi);
      #pragma unroll
      for(int d0=0;d0<2;++d0)stg[orow*64+d0*32+r32]=__float2bfloat16(o[d0][r]*rli[r]);}
    asm volatile("s_waitcnt lgkmcnt(0)":::"memory");
    #pragma unroll
    for(int i=0;i<4;++i){const int row=i*8+(lane>>3),ch=lane&7; const u32x4 v=*(const u32x4*)(stg+row*64+ch*8); ATTN_STORE16(Ow+(long)row*ldo+ch*8,v);} }
  asm volatile("s_waitcnt lgkmcnt(0)\n\ts_barrier":::"memory");
  #undef DMA_K
  #undef DMA_V
  #undef CMASK
  #undef START
  #undef RESC
  #undef ROT
}
constexpr int ATTN_LDS_BYTES=LDS_BYTES;
#undef SBAR
#undef WAIT_BAR
}

constexpr int NWAVES = 8;
constexpr int NB = 8, SEQ = 2048, D = 1024, M = NB * SEQ, MEMT = 256, DIN = 2304, NE = 32, TOPK = 4, CAP = M;
constexpr float ALPHA = 1.189207115002721f;
constexpr float LN_EPS = 1e-5f, RMS_EPS = 1e-6f, LAMBDA_INIT = 0.2f;
constexpr float LOG2E = 1.4426950408889634f;
constexpr float C2M = 0.0625f * LOG2E;
constexpr int HROWS = 73728;
constexpr int NPHASE = 17;

constexpr size_t MiB = 1u << 20;
constexpr size_t WS_CTL = 0, CTL_ZERO_BYTES = 1 * MiB;
constexpr size_t WS_WIN = 1 * MiB;
constexpr size_t WS_WMIX = 6 * MiB;
constexpr size_t WS_WQ = 8 * MiB;
constexpr size_t WS_WKV = 10 * MiB;
constexpr size_t WS_WO = 14 * MiB;
constexpr size_t WS_TAB = 16 * MiB;
constexpr size_t WS_WD = 17 * MiB;
constexpr size_t WS_WGU = 81 * MiB;
constexpr size_t WS_XB = 209 * MiB;
constexpr size_t WS_HRAW = 241 * MiB;
constexpr size_t WS_S = 241 * MiB, WS_X2 = 241 * MiB;
constexpr size_t WS_QA = 313 * MiB, WS_KA = 329 * MiB, WS_QB = 333 * MiB, WS_KB = 349 * MiB;
constexpr size_t WS_X1 = 313 * MiB;
constexpr size_t WS_OT = 377 * MiB;
constexpr size_t WS_QM = 377 * MiB, WS_P = 409 * MiB, WS_XO = 377 * MiB;
constexpr size_t WS_AO = 441 * MiB;
constexpr size_t WS_MEMK = 473 * MiB, WS_MEMVT = 477 * MiB, WS_MEMB = 481 * MiB;
constexpr size_t WS_LIST = 485 * MiB;
constexpr size_t WS_SEL = 487 * MiB;
constexpr size_t WS_H = 305 * MiB;
constexpr size_t WS_Y = 81 * MiB;
constexpr size_t WS_END = 512 * MiB;
constexpr int TB_COSS = 0, TB_SINS = 65536, TB_COSR = 131072, TB_SINR = 131584, TB_COSC = 132096, TB_SINC = 133120, TB_WRT = 134144;
constexpr int CW_TMO = 0, CW_CODE = 1, CW_CNT = 2048  , CW_BAR = 4096  ;

constexpr int RING_OFF = 0, RING_BYTES = 131072;
constexpr int IDX_OFF = RING_BYTES, IDX_BYTES = 12 * 1024;
constexpr int TILE_OFF = IDX_OFF + IDX_BYTES;
constexpr int TILE_BYTES = 320 * 4 + 32 * 4 + 32 * 4 + 16;
constexpr int LDSCTL_OFF = TILE_OFF + TILE_BYTES, MISC_OFF = LDSCTL_OFF + 64;
constexpr int LDS_BYTES = 147456;
static_assert(MISC_OFF + 128 <= LDS_BYTES, "LDS map");
#define GAS __attribute__((address_space(1)))
#define LAS __attribute__((address_space(3)))
typedef unsigned short bf16;
typedef unsigned v4u __attribute__((ext_vector_type(4)));
typedef float f32x4 __attribute__((ext_vector_type(4)));
typedef short bf16x8 __attribute__((ext_vector_type(8)));
typedef GAS unsigned gu32;
typedef GAS unsigned long long gu64;
#define RLX_AGENT __ATOMIC_RELAXED, __HIP_MEMORY_SCOPE_AGENT
#define LDS_WAIT() asm volatile("s_waitcnt lgkmcnt(0)" ::: "memory")
#define VM_WAIT() asm volatile("s_waitcnt vmcnt(0)" ::: "memory")
__device__ __forceinline__ unsigned long long rt() { return __builtin_amdgcn_s_memrealtime(); }
__device__ __forceinline__ unsigned f2bf(float f) { unsigned u = __builtin_bit_cast(unsigned, f); return (u + 0x7fffu + ((u >> 16) & 1u)) >> 16; }
__device__ __forceinline__ unsigned pk2(float lo, float hi) { return f2bf(lo) | (f2bf(hi) << 16); }

#define XB_TMO      128
#define XB_XCNT(j)  (256  + 64 * (j))
#define XB_XSUB(j)  (1280 + 64 * (j))
#define XB_XGEN(j)  (2304 + 64 * (j))
#define XB_TOP      3328
#define XB_TOPGEN   3392
#define XCD_BAR_WORDS 3456
#define XB_SPIN_CAP (1u << 18)

__device__ __forceinline__ unsigned xb_ld(unsigned* p)              { return __hip_atomic_load(p, __ATOMIC_RELAXED, __HIP_MEMORY_SCOPE_AGENT); }
__device__ __forceinline__ unsigned xb_add(unsigned* p, unsigned v) { return __hip_atomic_fetch_add(p, v, __ATOMIC_RELAXED, __HIP_MEMORY_SCOPE_AGENT); }
__device__ __forceinline__ unsigned xb_xcc_id() { return (unsigned)__builtin_amdgcn_s_getreg((3 << 11) | 20) & 0xFu; }
#define XB_SPIN(cond, bar) do { unsigned _sp = 0; while (cond) { __builtin_amdgcn_s_sleep(1); \
    if ((++_sp & 255u) == 0u) { if (xb_ld(&(bar)[XB_TMO])) break; if (_sp > XB_SPIN_CAP) { atomicAdd(&(bar)[XB_TMO], 1u); break; } } } } while (0)

struct XcdBarrier {
    unsigned* bar; unsigned x;
    volatile LAS unsigned* st;
};

__device__ __forceinline__ XcdBarrier xcd_barrier_post(unsigned* bar, volatile LAS unsigned* st) {
    XcdBarrier b; b.bar = bar; b.x = xb_xcc_id(); b.st = st;
    if (threadIdx.x == 0) (void)xb_add(&bar[XB_XCNT(b.x)], 1u);
    return b;
}
__device__ __forceinline__ void xcd_barrier_complete(unsigned* bar, unsigned x, unsigned& nloc, unsigned& nx) {
    const unsigned G = gridDim.x * gridDim.y * gridDim.z;
    unsigned sum, cnt, mine, sp = 0u;
    for (;;) {
        sum = 0u; cnt = 0u; mine = 0u;
#pragma unroll
        for (unsigned j = 0; j < 16; ++j) { const unsigned c = xb_ld(&bar[XB_XCNT(j)]); sum += c; cnt += (c > 0u) ? 1u : 0u; mine = (j == x) ? c : mine; }
        if (sum == G) break;
        __builtin_amdgcn_s_sleep(1);
        if ((++sp & 255u) == 0u) { if (xb_ld(&bar[XB_TMO])) break; if (sp > XB_SPIN_CAP) { atomicAdd(&bar[XB_TMO], 1u); break; } }
    }
    nloc = mine > 0u ? mine : 1u; nx = cnt > 0u ? cnt : 1u;
}

__device__ __forceinline__ void xcd_barrier(const XcdBarrier& b) {
    asm volatile("s_waitcnt vmcnt(0)" ::: "memory");
    __syncthreads();
    if (threadIdx.x == 0) {
        unsigned* bar = b.bar;
        __builtin_amdgcn_s_waitcnt(0);
        unsigned nloc = b.st[0], nx = b.st[1];
        if (nloc == 0u) { xcd_barrier_complete(bar, b.x, nloc, nx); b.st[0] = nloc; b.st[1] = nx; }
        const unsigned old = xb_add(&bar[XB_XSUB(b.x)], 1u);
        const unsigned gen = old / nloc;
        if (old + 1u == (gen + 1u) * nloc) {
            __builtin_amdgcn_fence(__ATOMIC_RELEASE, "agent");
            asm volatile("s_waitcnt vmcnt(0)" ::: "memory");
            const unsigned og = xb_add(&bar[XB_TOP], 1u);
            const unsigned tg = og / nx;
            if (og + 1u == (tg + 1u) * nx) xb_add(&bar[XB_TOPGEN], 1u);
            else XB_SPIN(xb_ld(&bar[XB_TOPGEN]) == tg, bar);
            __builtin_amdgcn_fence(__ATOMIC_ACQUIRE, "agent");
            xb_add(&bar[XB_XGEN(b.x)], 1u);
            asm volatile("s_waitcnt vmcnt(0)" ::: "memory");
        } else {
            XB_SPIN(xb_ld(&bar[XB_XGEN(b.x)]) == gen, bar);
            __builtin_amdgcn_fence(__ATOMIC_ACQUIRE, "agent");
            asm volatile("s_waitcnt vmcnt(0)" ::: "memory");
        }
    }
    __syncthreads();
}

struct Frame {
    LAS unsigned char* lds;
    volatile LAS unsigned* MISC;
    gu32* ctl;
    int tid, lane, wave, vcu, G;
    unsigned char* ws;
};
__device__ __forceinline__ float wave_sum(float v) {
#pragma unroll
    for (int o = 1; o < 64; o <<= 1) v += __shfl_xor(v, o);
    return v;
}
__device__ __forceinline__ float wave_max(float v) {
#pragma unroll
    for (int o = 1; o < 64; o <<= 1) v = fmaxf(v, __shfl_xor(v, o));
    return v;
}
__device__ __forceinline__ float bf2f(unsigned short b) { return __uint_as_float((unsigned)b << 16); }

__device__ __forceinline__ void p0_transpose_item(const float* W, int K, int N, bf16* WT, int kb, int n0, int drow0, LAS float* scr, int lane) {
    const int k0 = 64 * kb;
#pragma unroll 8
    for (int i = 0; i < 32; ++i) { const int kk = 2 * i + (lane >> 5); scr[kk * 33 + (lane & 31)] = W[(size_t)(k0 + kk) * N + n0 + (lane & 31)]; }
    LDS_WAIT(); asm volatile("" ::: "memory");
    const int c = lane & 7;
#pragma unroll
    for (int j = 0; j < 4; ++j) { const int n = (lane >> 3) + 8 * j; const LAS float* s = scr + (8 * c) * 33 + n;
        v4u o; o.x = pk2(s[0 * 33], s[1 * 33]); o.y = pk2(s[2 * 33], s[3 * 33]); o.z = pk2(s[4 * 33], s[5 * 33]); o.w = pk2(s[6 * 33], s[7 * 33]);
        *(GAS v4u*)(WT + (size_t)(drow0 + n) * K + k0 + 8 * c) = o; }
    LDS_WAIT(); asm volatile("" ::: "memory");
}
__device__ __forceinline__ void row_f32_to_bf16(const float* xrow, bf16* orow, int lane) {
    const GAS f32x4* xr = (const GAS f32x4*)xrow + lane;
    GAS unsigned long long* o8 = (GAS unsigned long long*)orow + lane;
#pragma unroll
    for (int j = 0; j < 4; ++j) { const f32x4 v = xr[64 * j]; o8[64 * j] = (unsigned long long)pk2(v.x, v.y) | ((unsigned long long)pk2(v.z, v.w) << 32); }
}
struct Ins { const float* p[28]; };
__device__ __forceinline__ void p0_prologue(Frame& F, const Ins& I) {
    LAS float* scr = (LAS float*)(F.lds + RING_OFF + F.wave * 16384);
    const int gw = F.vcu * NWAVES + F.wave, NGW = F.G * NWAVES;
    unsigned char* ws = F.ws;
    constexpr int I_IN = 16 * 72, I_SQ = 16 * 32, I_KV = 16 * 64, I_SMALL = I_IN + 3 * I_SQ + I_KV, NITEMS = I_SMALL + NE * 3 * I_SQ;
    for (int it = gw; it < NITEMS; it += NGW) {
        int r = it;
        if (r < I_IN) { p0_transpose_item(I.p[2], D, DIN, (bf16*)(ws + WS_WIN), r / 72, 32 * (r % 72), 32 * (r % 72), scr, F.lane); continue; } r -= I_IN;
        if (r < I_SQ) { p0_transpose_item(I.p[10], D, D, (bf16*)(ws + WS_WMIX), r / 32, 32 * (r % 32), 32 * (r % 32), scr, F.lane); continue; } r -= I_SQ;
        if (r < I_SQ) { p0_transpose_item(I.p[13], D, D, (bf16*)(ws + WS_WQ), r / 32, 32 * (r % 32), 32 * (r % 32), scr, F.lane); continue; } r -= I_SQ;
        if (r < I_KV) { p0_transpose_item(I.p[14], D, 2 * D, (bf16*)(ws + WS_WKV), r / 64, 32 * (r % 64), 32 * (r % 64), scr, F.lane); continue; } r -= I_KV;
        if (r < I_SQ) { p0_transpose_item(I.p[15], D, D, (bf16*)(ws + WS_WO), r / 32, 32 * (r % 32), 32 * (r % 32), scr, F.lane); continue; } r -= I_SQ;
        const int e = r / (3 * I_SQ), q = r % (3 * I_SQ), which = q / I_SQ, j = q % I_SQ, kb = j / 32, n0 = 32 * (j % 32);
        if (which == 0)      p0_transpose_item(I.p[20] + (size_t)e * D * D, D, D, (bf16*)(ws + WS_WGU) + (size_t)e * 2048 * D, kb, n0, (n0 >> 7) * 256 + (n0 & 127), scr, F.lane);
        else if (which == 1) p0_transpose_item(I.p[22] + (size_t)e * D * D, D, D, (bf16*)(ws + WS_WGU) + (size_t)e * 2048 * D, kb, n0, (n0 >> 7) * 256 + 128 + (n0 & 127), scr, F.lane);
        else                 p0_transpose_item(I.p[24] + (size_t)e * D * D, D, D, (bf16*)(ws + WS_WD) + (size_t)e * D * D, kb, n0, n0, scr, F.lane);
    }
    for (int m = gw; m < M; m += NGW) row_f32_to_bf16(I.p[0] + (size_t)m * D, (bf16*)(ws + WS_XB) + (size_t)m * D, F.lane);
    for (int m = gw; m < NB * MEMT; m += NGW) row_f32_to_bf16(I.p[1] + (size_t)m * D, (bf16*)(ws + WS_MEMB) + (size_t)m * D, F.lane);
    float* tab = (float*)(ws + WS_TAB);
    const int gt = F.vcu * (NWAVES * 64) + F.tid, NGT = F.G * NWAVES * 64;
    for (int i = gt; i < 65536; i += NGT) { const int s = i >> 5, f = i & 31; const float inv = powf(10000.0f, -(float)(2 * f) / 64.0f); const float ang = (float)s * inv; tab[TB_COSS + i] = cosf(ang); tab[TB_SINS + i] = sinf(ang); }
    for (int i = gt; i < 1536; i += NGT) {
        const bool isr = i < 512; const int j = isr ? i : i - 512, pos = j >> 4, f = j & 15; const float inv = powf(10000.0f, -(float)(2 * f) / 32.0f); const float ang = (float)pos * inv;
        if (isr) { tab[TB_COSR + j] = cosf(ang); tab[TB_SINR + j] = sinf(ang); } else { tab[TB_COSC + j] = cosf(ang); tab[TB_SINC + j] = sinf(ang); } }
    for (int i = gt; i < 32768; i += NGT) { const int e = i >> 10, k = i & 1023; tab[TB_WRT + i] = I.p[18][(size_t)k * NE + e]; }
}

struct SchedP1 {
    int G, c; const char* xb; const char* win; const char* memb; const char* wkv; bf16* hraw; bf16* memk; bf16* memvt;
    __device__ __forceinline__ bool next(int i, pg8::Unit& u) const {
        const long L = (long)i * G + c; u.gidx = 0; u.aux = 0;
        if (L < 576) { const int nM = 64, nN = 9, nwg = 576; int wgid = (int)L; { const int q = nwg / 8, xcd = wgid % 8, off = wgid / 8; wgid = xcd * q + off; }
            const int nig = 8 * nN, gid = wgid / nig, fm = gid * 8, gsz = (nM - fm) < 8 ? (nM - fm) : 8; const int pm = fm + ((wgid % nig) % gsz), pn = (wgid % nig) / gsz;
            u.A = xb + (size_t)pm * 256 * 2048; u.B = win + (size_t)pn * 256 * 2048; u.orow = pm * 256; u.ocol = pn * 256; u.O = hraw; u.ldo = DIN; return true; }
        if (L < 608) { const int j = (int)L - 576, pm = j >> 2, pn = j & 3; u.A = memb + (size_t)pm * 256 * 2048; u.B = wkv + (size_t)pn * 256 * 2048; u.orow = pm * 256; u.ocol = pn * 256; u.O = memk; u.ldo = D; return true; }
        if (L < 640) { const int j = (int)L - 608, b = j >> 2, pm = j & 3; u.A = wkv + (size_t)(1024 + pm * 256) * 2048; u.B = memb + (size_t)b * 256 * 2048; u.orow = b * 1024 + pm * 256; u.ocol = 0; u.O = memvt; u.ldo = 256; return true; }
        return false;
    }
};
struct SchedPlain {
    int nM, nN, nwg, G, c; const char* A; const char* B; size_t astep, bstep;
    __device__ __forceinline__ bool next(int i, pg8::Unit& u) const {
        const long L = (long)i * G + c; if (L >= nwg) return false;
        int wgid = (int)L; { const int q = nwg / 8, r = nwg % 8, xcd = wgid % 8, off = wgid / 8; wgid = (xcd < r ? xcd * (q + 1) : r * (q + 1) + (xcd - r) * q) + off; }
        const int nig = 8 * nN, gid = wgid / nig, fm = gid * 8, gsz = (nM - fm) < 8 ? (nM - fm) : 8; const int pm = fm + ((wgid % nig) % gsz), pn = (wgid % nig) / gsz;
        u.A = A + (size_t)pm * astep; u.B = B + (size_t)pn * bstep; u.orow = pm * 256; u.ocol = pn * 256; u.O = nullptr; u.ldo = 0; u.aux = 0; u.gidx = 0; return true;
    }
};

__device__ __forceinline__ void t1_norm_rope(Frame& F, const Ins& I) {
    unsigned char* ws = F.ws; const int lane = F.lane;
    const bf16* hraw = (const bf16*)(ws + WS_HRAW); const float* tab = (const float*)(ws + WS_TAB);
    bf16* QA = (bf16*)(ws + WS_QA); bf16* KA = (bf16*)(ws + WS_KA); bf16* QB = (bf16*)(ws + WS_QB); bf16* KB = (bf16*)(ws + WS_KB);
    const float gq = I.p[3][lane], gk = I.p[4][lane];
    const int gw = F.vcu * NWAVES + F.wave, NGW = F.G * NWAVES;
    const float C2A = 0.125f * LOG2E;
    for (int t = gw; t < M; t += NGW) {
        const int s = t & (SEQ - 1); const bf16* hr = hraw + (size_t)t * DIN;
        float va[10], vb[16];
#pragma unroll
        for (int j = 0; j < 10; ++j) va[j] = bf2f(hr[j * 64 + lane]);
#pragma unroll
        for (int j = 0; j < 16; ++j) vb[j] = bf2f(hr[768 + j * 64 + lane]);
        {
            const int sub = lane >> 5, jj = lane & 31, f = jj & 15, pos = sub == 0 ? (s >> 6) : (s & 63);
            const float c = sub == 0 ? tab[TB_COSR + pos * 16 + f] : tab[TB_COSC + pos * 16 + f], sn = sub == 0 ? tab[TB_SINR + pos * 16 + f] : tab[TB_SINC + pos * 16 + f];
#pragma unroll
            for (int j = 0; j < 10; ++j) {
                const float ss = wave_sum(va[j] * va[j]);
                const float y = va[j] * (1.0f / sqrtf(ss * (1.0f / 64.0f) + RMS_EPS)) * (j < 8 ? gq : gk);
                const float p = __shfl_xor(y, 16);
                float o = (jj < 16) ? (y * c - p * sn) : (y * c + p * sn);
                if (j < 8) QA[(size_t)t * 512 + j * 64 + lane] = (bf16)f2bf(o * C2A); else KA[(size_t)t * 128 + (j - 8) * 64 + lane] = (bf16)f2bf(o);
            }
        }
        {
            const int f = lane & 31; const float c = tab[TB_COSS + s * 32 + f], sn = tab[TB_SINS + s * 32 + f];
#pragma unroll
            for (int j = 0; j < 16; ++j) {
                const float p = __shfl_xor(vb[j], 32);
                const float o = (lane < 32) ? (vb[j] * c - p * sn) : (vb[j] * c + p * sn);
                if (j < 8) QB[(size_t)t * 512 + j * 64 + lane] = (bf16)f2bf(o * C2A); else KB[(size_t)t * 512 + (j - 8) * 64 + lane] = (bf16)f2bf(o);
            }
        }
    }
}

__device__ __forceinline__ bool attn_unit_ptrs(unsigned char* ws, long L, attn_body::AttnPtrs& P, int& qb) {
    using abf = __hip_bfloat16;
    if (L >= 1536) return false;
    const int r = (int)(L >> 8), v = (int)(L & 255), xcd = v >> 5, w = v & 31; qb = w & 7;
    if (r < 2) { const int idx = r * 8 + xcd, b = idx >> 1, g = idx & 1, h = g * 4 + (w >> 3);
        P.Q = (const abf*)(ws + WS_QA) + (size_t)b * SEQ * 512 + h * 64; P.ldq = 512;
        P.K = (const abf*)(ws + WS_KA) + (size_t)b * SEQ * 128 + g * 64; P.ldk = 128;
        P.V = (const abf*)(ws + WS_HRAW) + (size_t)b * SEQ * DIN + 640 + g * 64; P.ldv = DIN;
        P.O = (abf*)(ws + WS_AO) + (size_t)b * SEQ * 1024 + h * 64; P.ldo = 1024;
    } else { const int idx = (r - 2) * 8 + xcd, b = idx >> 2, h = idx & 3, c = w >> 4, vh = (w >> 3) & 1;
        P.Q = (const abf*)(ws + WS_QB) + (size_t)b * SEQ * 512 + (h * 2 + c) * 64; P.ldq = 512;
        P.K = (const abf*)(ws + WS_KB) + (size_t)b * SEQ * 512 + (h * 2 + c) * 64; P.ldk = 512;
        P.V = (const abf*)(ws + WS_HRAW) + (size_t)b * SEQ * DIN + 1792 + h * 128 + vh * 64; P.ldv = DIN;
        P.O = (abf*)(ws + WS_OT) + (size_t)c * M * 512 + (size_t)b * SEQ * 512 + h * 128 + vh * 64; P.ldo = 512;
    }
    return true;
}

__device__ __forceinline__ void t2_diff_combine(Frame& F, const Ins& I) {
    unsigned char* ws = F.ws; const int lane = F.lane;
    const bf16* OT = (const bf16*)(ws + WS_OT); bf16* AO = (bf16*)(ws + WS_AO);
    const float lam = expf(wave_sum(I.p[5][lane] * I.p[6][lane])) - expf(wave_sum(I.p[7][lane] * I.p[8][lane])) + LAMBDA_INIT;
    const float g0 = I.p[9][2 * lane] * (1.0f - LAMBDA_INIT), g1 = I.p[9][2 * lane + 1] * (1.0f - LAMBDA_INIT);
    const int gw = F.vcu * NWAVES + F.wave, NGW = F.G * NWAVES;
    for (int it = gw; it < M * 4; it += NGW) {
        const int t = it >> 2, hh = it & 3;
        const unsigned a = *(const GAS unsigned*)(OT + (size_t)t * 512 + hh * 128 + 2 * lane), b = *(const GAS unsigned*)(OT + (size_t)M * 512 + (size_t)t * 512 + hh * 128 + 2 * lane);
        const float v0 = bf2f((unsigned short)(a & 0xffffu)) - lam * bf2f((unsigned short)(b & 0xffffu)), v1 = bf2f((unsigned short)(a >> 16)) - lam * bf2f((unsigned short)(b >> 16));
        const float ss = wave_sum(v0 * v0 + v1 * v1);
        const float r = 1.0f / sqrtf(ss * (1.0f / 128.0f) + RMS_EPS);
        *(GAS unsigned*)(AO + (size_t)t * 1024 + 512 + hh * 128 + 2 * lane) = pk2(v0 * r * g0, v1 * r * g1);
    }
}

__device__ __forceinline__ void ln_rows(Frame& F, float* X, bf16* XB, const float* g, const float* bta) {
    const int lane = F.lane; const int gw = F.vcu * NWAVES + F.wave, NGW = F.G * NWAVES;
    f32x4 gg[4], bb[4];
#pragma unroll
    for (int j = 0; j < 4; ++j) { gg[j] = ((const GAS f32x4*)g)[lane + 64 * j]; bb[j] = ((const GAS f32x4*)bta)[lane + 64 * j]; }
    for (int m = gw; m < M; m += NGW) {
        GAS f32x4* xr = (GAS f32x4*)(X + (size_t)m * D) + lane;
        f32x4 v[4]; float s = 0.f;
#pragma unroll
        for (int j = 0; j < 4; ++j) { v[j] = xr[64 * j]; s += (v[j].x + v[j].y) + (v[j].z + v[j].w); }
        const float mean = wave_sum(s) * (1.f / D); float s2 = 0.f;
#pragma unroll
        for (int j = 0; j < 4; ++j) { v[j] = v[j] - mean; s2 += (v[j].x * v[j].x + v[j].y * v[j].y) + (v[j].z * v[j].z + v[j].w * v[j].w); }
        const float rstd = 1.f / sqrtf(wave_sum(s2) * (1.f / D) + LN_EPS);
        GAS unsigned long long* o8 = (GAS unsigned long long*)(XB + (size_t)m * D) + lane;
#pragma unroll
        for (int j = 0; j < 4; ++j) { const f32x4 o = v[j] * rstd * gg[j] + bb[j]; xr[64 * j] = o;
            o8[64 * j] = (unsigned long long)pk2(o.x, o.y) | ((unsigned long long)pk2(o.z, o.w) << 32); }
    }
}

__device__ __forceinline__ void t4_softmax(Frame& F) {
    const float* S = (const float*)(F.ws + WS_S); bf16* P = (bf16*)(F.ws + WS_P); const int lane = F.lane;
    const int gw = F.vcu * NWAVES + F.wave, NGW = F.G * NWAVES;
    for (int r = gw; r < M * 4; r += NGW) {
        f32x4 v = ((const GAS f32x4*)(S + (size_t)r * 256))[lane];
        const float mx = wave_max(fmaxf(fmaxf(v.x, v.y), fmaxf(v.z, v.w)));
        v.x = __builtin_amdgcn_exp2f(v.x - mx); v.y = __builtin_amdgcn_exp2f(v.y - mx); v.z = __builtin_amdgcn_exp2f(v.z - mx); v.w = __builtin_amdgcn_exp2f(v.w - mx);
        const float rs = 1.0f / wave_sum((v.x + v.y) + (v.z + v.w));
        ((GAS unsigned long long*)(P + (size_t)r * 256))[lane] = (unsigned long long)pk2(v.x * rs, v.y * rs) | ((unsigned long long)pk2(v.z * rs, v.w * rs) << 32);
    }
}

__device__ __forceinline__ void t5b_router(Frame& F, const Ins& I) {
    unsigned char* ws = F.ws; const int lane = F.lane, fr = lane & 15, fq = lane >> 4;
    const float* X2 = (const float*)(ws + WS_X2); const float* wrT = (const float*)(ws + WS_TAB) + TB_WRT;
    int* list = (int*)(ws + WS_LIST); int* sel_e = (int*)(ws + WS_SEL); int* sel_pos = sel_e + M * 4; float* sel_g = (float*)(sel_pos + M * 4);
    LAS float* lg = (LAS float*)(F.lds + RING_OFF + F.wave * 16384);
    for (int blk = F.wave * F.G + F.vcu; blk < M / 16; blk += NWAVES * F.G) {
        const int r0 = blk * 16;
        const GAS f32x4* ap = (const GAS f32x4*)(X2 + (size_t)(r0 + fr) * D + fq * 256);
        const GAS f32x4* b0p = (const GAS f32x4*)(wrT + (size_t)fr * D + fq * 256);
        const GAS f32x4* b1p = (const GAS f32x4*)(wrT + (size_t)(16 + fr) * D + fq * 256);
        f32x4 acc0 = {0.f, 0.f, 0.f, 0.f}, acc1 = {0.f, 0.f, 0.f, 0.f};
#pragma unroll 4
        for (int ks = 0; ks < 64; ++ks) {
            const f32x4 a = ap[ks], b0 = b0p[ks], b1 = b1p[ks];
            acc0 = __builtin_amdgcn_mfma_f32_16x16x4f32(a.x, b0.x, acc0, 0, 0, 0); acc1 = __builtin_amdgcn_mfma_f32_16x16x4f32(a.x, b1.x, acc1, 0, 0, 0);
            acc0 = __builtin_amdgcn_mfma_f32_16x16x4f32(a.y, b0.y, acc0, 0, 0, 0); acc1 = __builtin_amdgcn_mfma_f32_16x16x4f32(a.y, b1.y, acc1, 0, 0, 0);
            acc0 = __builtin_amdgcn_mfma_f32_16x16x4f32(a.z, b0.z, acc0, 0, 0, 0); acc1 = __builtin_amdgcn_mfma_f32_16x16x4f32(a.z, b1.z, acc1, 0, 0, 0);
            acc0 = __builtin_amdgcn_mfma_f32_16x16x4f32(a.w, b0.w, acc0, 0, 0, 0); acc1 = __builtin_amdgcn_mfma_f32_16x16x4f32(a.w, b1.w, acc1, 0, 0, 0);
        }
#pragma unroll
        for (int r = 0; r < 4; ++r) { lg[(4 * fq + r) * 33 + fr] = acc0[r]; lg[(4 * fq + r) * 33 + 16 + fr] = acc1[r]; }
        LDS_WAIT(); asm volatile("" ::: "memory");
        if (lane < 16) {
            const int t = r0 + lane;
            float l[NE];
#pragma unroll
            for (int e = 0; e < NE; ++e) l[e] = lg[lane * 33 + e] + I.p[19][e];
            int sel[TOPK]; float sv[TOPK];
#pragma unroll
            for (int k = 0; k < TOPK; ++k) {
                float best = -INFINITY; int bi = 0;
#pragma unroll
                for (int e = 0; e < NE; ++e) { const bool taken = (k > 0 && sel[0] == e) || (k > 1 && sel[1] == e) || (k > 2 && sel[2] == e); if (!taken && l[e] > best) { best = l[e]; bi = e; } }
                sel[k] = bi; sv[k] = best;
            }
            float ex[TOPK], sum = 0.f;
#pragma unroll
            for (int k = 0; k < TOPK; ++k) { ex[k] = expf(sv[k] - sv[0]); sum += ex[k]; }
            const float rs = 1.0f / sum;
#pragma unroll
            for (int k = 0; k < TOPK; ++k) {
                const int pos = (int)__hip_atomic_fetch_add((unsigned*)(F.ctl + CW_CNT + sel[k]), 1u, __ATOMIC_RELAXED, __HIP_MEMORY_SCOPE_AGENT);
                list[(size_t)sel[k] * CAP + pos] = t;
                sel_e[t * 4 + k] = sel[k]; sel_pos[t * 4 + k] = pos; sel_g[t * 4 + k] = ex[k] * rs;
            }
        }
        LDS_WAIT(); asm volatile("" ::: "memory");
    }
}

__device__ __forceinline__ void moe_tables(Frame& F) {
    LAS int* tileE = (LAS int*)(F.lds + TILE_OFF); LAS int* tbase = tileE + 320; LAS int* cntS = tbase + 32; LAS int* Tp = cntS + 32;
    __syncthreads();
    if (F.tid < 32) cntS[F.tid] = (int)__hip_atomic_load((unsigned*)(F.ctl + CW_CNT + F.tid), __ATOMIC_RELAXED, __HIP_MEMORY_SCOPE_AGENT);
    __syncthreads();
    if (F.tid == 0) { int a = 0; for (int e = 0; e < NE; ++e) { tbase[e] = a; const int n = (cntS[e] + 255) >> 8; for (int j = 0; j < n; ++j) tileE[a + j] = e; a += n; } *Tp = a; }
    __syncthreads();
}
struct SchedGU {
    int vcu, T; LAS unsigned char* lds; const char* x2b; const char* wgu;
    __device__ __forceinline__ bool next(int i, pg8::Unit& u) const {
        const int tt = i * 32 + (vcu >> 3); if (tt >= T || i >= 12) return false;
        const int e = ((const LAS int*)(lds + TILE_OFF))[tt], pn = vcu & 7;
        u.A = x2b; u.B = wgu + ((size_t)e * 2048 + (size_t)pn * 256) * 2048; u.orow = tt * 256; u.ocol = pn * 128; u.O = nullptr; u.ldo = 0; u.aux = e; u.gidx = IDX_OFF + i * 1024; return true;
    }
};
struct SchedDown {
    int vcu, T; LAS unsigned char* lds; const char* h; const char* wd;
    __device__ __forceinline__ bool next(int i, pg8::Unit& u) const {
        const int tt = i * 64 + (vcu >> 2); if (tt >= T) return false;
        const int e = ((const LAS int*)(lds + TILE_OFF))[tt], pn = vcu & 3;
        u.A = h + (size_t)tt * 256 * 2048; u.B = wd + ((size_t)e * 1024 + (size_t)pn * 256) * 2048; u.orow = tt * 256; u.ocol = pn * 256; u.O = nullptr; u.ldo = 0; u.aux = e; u.gidx = 0; return true;
    }
};

__device__ __forceinline__ void t6_combine_ln(Frame& F, const Ins& I, float* out) {
    unsigned char* ws = F.ws; const int lane = F.lane;
    const float* X2 = (const float*)(ws + WS_X2); const bf16* Y = (const bf16*)(ws + WS_Y);
    const int* sel_e = (const int*)(ws + WS_SEL); const int* sel_pos = sel_e + M * 4; const float* sel_g = (const float*)(sel_pos + M * 4);
    const LAS int* tbase = (const LAS int*)(F.lds + TILE_OFF) + 320;
    const int gw = F.vcu * NWAVES + F.wave, NGW = F.G * NWAVES;
    f32x4 gg[4], bb[4];
#pragma unroll
    for (int j = 0; j < 4; ++j) { gg[j] = ((const GAS f32x4*)I.p[26])[lane + 64 * j]; bb[j] = ((const GAS f32x4*)I.p[27])[lane + 64 * j]; }
    for (int t = gw; t < M; t += NGW) {
        const GAS f32x4* xr = (const GAS f32x4*)(X2 + (size_t)t * D) + lane;
        f32x4 v[4];
#pragma unroll
        for (int j = 0; j < 4; ++j) v[j] = xr[64 * j] * ALPHA;
#pragma unroll
        for (int k = 0; k < TOPK; ++k) {
            const int e = sel_e[t * 4 + k], pos = sel_pos[t * 4 + k]; const float gt = sel_g[t * 4 + k];
            const GAS unsigned long long* yr = (const GAS unsigned long long*)(Y + ((size_t)tbase[e] * 256 + pos) * D) + lane;
#pragma unroll
            for (int j = 0; j < 4; ++j) { const unsigned long long w = yr[64 * j]; const unsigned lo = (unsigned)w, hi = (unsigned)(w >> 32);
                v[j].x += gt * __uint_as_float(lo << 16); v[j].y += gt * __uint_as_float(lo & 0xffff0000u); v[j].z += gt * __uint_as_float(hi << 16); v[j].w += gt * __uint_as_float(hi & 0xffff0000u); }
        }
        float s = 0.f;
#pragma unroll
        for (int j = 0; j < 4; ++j) s += (v[j].x + v[j].y) + (v[j].z + v[j].w);
        const float mean = wave_sum(s) * (1.f / D); float s2 = 0.f;
#pragma unroll
        for (int j = 0; j < 4; ++j) { v[j] = v[j] - mean; s2 += (v[j].x * v[j].x + v[j].y * v[j].y) + (v[j].z * v[j].z + v[j].w * v[j].w); }
        const float rstd = 1.f / sqrtf(wave_sum(s2) * (1.f / D) + LN_EPS);
        GAS f32x4* orow = (GAS f32x4*)(out + (size_t)t * D) + lane;
#pragma unroll
        for (int j = 0; j < 4; ++j) orow[64 * j] = v[j] * rstd * gg[j] + bb[j];
    }
}

struct Args { const float* in[28]; float* out; unsigned char* ws; int ph_lo, ph_hi, li, pad; };
__global__ void __launch_bounds__(NWAVES * 64, 2) mk_fwd(Args args) {
    extern __shared__ __attribute__((aligned(16))) unsigned char lds[];
    Frame F;
    F.lds = (LAS unsigned char*)lds;
    F.MISC = (volatile LAS unsigned*)(F.lds + MISC_OFF);
    F.tid = threadIdx.x; F.lane = F.tid & 63; F.wave = __builtin_amdgcn_readfirstlane(F.tid >> 6);
    F.G = gridDim.x; { const int bx = blockIdx.x; F.vcu = (F.G % 8 == 0) ? (bx % 8) * (F.G / 8) + bx / 8 : bx; }
    F.ws = args.ws; F.ctl = (gu32*)(args.ws + WS_CTL);
    unsigned char* ws = args.ws;
    Ins I;
#pragma unroll
    for (int i = 0; i < 28; ++i) I.p[i] = args.in[i];
    for (int u = F.tid; u < (LDS_BYTES - LDSCTL_OFF) / 4; u += NWAVES * 64) ((LAS unsigned*)(F.lds + LDSCTL_OFF))[u] = 0u;
    __syncthreads();
    const int lo = args.ph_lo, hi = args.ph_hi;
    XcdBarrier bar; bar.bar = (unsigned*)(F.ctl + CW_BAR) + args.li * XCD_BAR_WORDS; bar.x = 0; bar.st = nullptr;
    if (hi - lo > 1) bar = xcd_barrier_post((unsigned*)(F.ctl + CW_BAR) + args.li * XCD_BAR_WORDS, F.MISC + 8);
#define IN(k) (lo <= (k) && (k) < hi)
#define SEAM(k) do { if (IN(k) && IN((k) + 1)) xcd_barrier(bar); } while (0)
    LAS unsigned char* ring = F.lds + RING_OFF;

    if (IN(0)) { p0_prologue(F, I); } SEAM(0);
    if (IN(1)) {
        pg8::Gemm g{D, D, D}; SchedP1 S{F.G, (int)blockIdx.x, (const char*)(ws + WS_XB), (const char*)(ws + WS_WIN), (const char*)(ws + WS_MEMB), (const char*)(ws + WS_WKV), (bf16*)(ws + WS_HRAW), (bf16*)(ws + WS_MEMK), (bf16*)(ws + WS_MEMVT)};
        pg8::EpiBf16 E{nullptr, 0, nullptr, 0, 1.0f};
        pg8::gemm_phase<pg8::EpiBf16, SchedP1, true, false>(ring, F.lds, g, S, E);
    } SEAM(1);
    if (IN(2)) { t1_norm_rope(F, I); } SEAM(2);
    if (IN(3)) {
        for (int i = 0;; ++i) { attn_body::AttnPtrs P; int qb; if (!attn_unit_ptrs(ws, (long)i * F.G + F.vcu, P, qb)) break; attn_body::attn_unit<8>(qb, P, (char*)lds + RING_OFF); }
    } SEAM(3);
    if (IN(4)) { t2_diff_combine(F, I); } SEAM(4);
    if (IN(5)) {
        pg8::Gemm g{D, D, D}; SchedPlain S{M / 256, 4, (M / 256) * 4, F.G, (int)blockIdx.x, (const char*)(ws + WS_AO), (const char*)(ws + WS_WMIX), (size_t)256 * 2048, (size_t)256 * 2048};
        pg8::EpiF32 E{(float*)(ws + WS_X1), I.p[0], D, ALPHA, 1.0f};
        pg8::gemm_phase<pg8::EpiF32, SchedPlain, true, false>(ring, F.lds, g, S, E);
    } SEAM(5);
    if (IN(6)) { ln_rows(F, (float*)(ws + WS_X1), (bf16*)(ws + WS_XB), I.p[11], I.p[12]); } SEAM(6);
    if (IN(7)) {
        pg8::Gemm g{D, D, D}; SchedPlain S{M / 256, 4, (M / 256) * 4, F.G, (int)blockIdx.x, (const char*)(ws + WS_XB), (const char*)(ws + WS_WQ), (size_t)256 * 2048, (size_t)256 * 2048};
        pg8::EpiBf16 E{(bf16*)(ws + WS_QM), D, nullptr, 0, C2M};
        pg8::gemm_phase<pg8::EpiBf16, SchedPlain, true, false>(ring, F.lds, g, S, E);
    } SEAM(7);
    if (IN(8)) {
        struct SchedS { int G, c; const char* qm; const char* mk_;
            __device__ __forceinline__ bool next(int i, pg8::Unit& u) const { const int L = i * G + c; if (L >= 256) return false; const int b = L >> 5, h = (L >> 3) & 3, q = L & 7;
                u.A = qm + ((size_t)(b * SEQ + q * 256) * D + h * 256) * 2; u.B = mk_ + ((size_t)(b * MEMT) * D + h * 256) * 2; u.orow = b * SEQ + q * 256; u.ocol = h * 256; u.O = nullptr; u.ldo = 0; u.aux = 0; u.gidx = 0; return true; } };
        pg8::Gemm g{D, D, 256}; SchedS S{F.G, F.vcu, (const char*)(ws + WS_QM), (const char*)(ws + WS_MEMK)};
        pg8::EpiF32 E{(float*)(ws + WS_S), nullptr, D, 0.f, 1.0f};
        pg8::gemm_phase<pg8::EpiF32, SchedS, true, false>(ring, F.lds, g, S, E);
    } SEAM(8);
    if (IN(9)) { t4_softmax(F); } SEAM(9);
    if (IN(10)) {
        struct SchedPV { int G, c; const char* p; const char* vt;
            __device__ __forceinline__ bool next(int i, pg8::Unit& u) const { const int L = i * G + c; if (L >= 256) return false; const int b = L >> 5, h = (L >> 3) & 3, q = L & 7;
                u.A = p + ((size_t)(b * SEQ + q * 256) * D + h * 256) * 2; u.B = vt + ((size_t)(b * 1024 + h * 256) * 256) * 2; u.orow = b * SEQ + q * 256; u.ocol = h * 256; u.O = nullptr; u.ldo = 0; u.aux = 0; u.gidx = 0; return true; } };
        pg8::Gemm g{D, 256, 256}; SchedPV S{F.G, F.vcu, (const char*)(ws + WS_P), (const char*)(ws + WS_MEMVT)};
        pg8::EpiBf16 E{(bf16*)(ws + WS_XO), D, nullptr, 0, 1.0f};
        pg8::gemm_phase<pg8::EpiBf16, SchedPV, true, false>(ring, F.lds, g, S, E);
    } SEAM(10);
    if (IN(11)) {
        pg8::Gemm g{D, D, D}; SchedPlain S{M / 256, 4, (M / 256) * 4, F.G, (int)blockIdx.x, (const char*)(ws + WS_XO), (const char*)(ws + WS_WO), (size_t)256 * 2048, (size_t)256 * 2048};
        pg8::EpiF32 E{(float*)(ws + WS_X2), (const float*)(ws + WS_X1), D, ALPHA, 1.0f};
        pg8::gemm_phase<pg8::EpiF32, SchedPlain, true, false>(ring, F.lds, g, S, E);
    } SEAM(11);
    if (IN(12)) { ln_rows(F, (float*)(ws + WS_X2), (bf16*)(ws + WS_XB), I.p[16], I.p[17]); } SEAM(12);
    if (IN(13)) { t5b_router(F, I); } SEAM(13);
    if (IN(14)) {
        moe_tables(F);
        const LAS int* tileE = (const LAS int*)(F.lds + TILE_OFF); const LAS int* tbase = tileE + 320; const LAS int* cntS = tbase + 32; const int T = tbase[64];
        const int* list = (const int*)(ws + WS_LIST);
        for (int i = 0; i < 12; ++i) { const int tt = i * 32 + (F.vcu >> 3); if (tt >= T) break;
            if (F.tid < 256) { const int e = tileE[tt], j = (tt - tbase[e]) * 256 + F.tid; ((LAS int*)(F.lds + IDX_OFF))[i * 256 + F.tid] = list[(size_t)e * CAP + (j < cntS[e] ? j : 0)]; } }
        __syncthreads();
        pg8::Gemm g{D, D, D}; SchedGU S{F.vcu, T, F.lds, (const char*)(ws + WS_XB), (const char*)(ws + WS_WGU)};
        pg8::EpiSwiglu E{(bf16*)(ws + WS_H), D, I.p[21], I.p[23]};
        pg8::gemm_phase<pg8::EpiSwiglu, SchedGU, true, true>(ring, F.lds, g, S, E);
    } SEAM(14);
    if (IN(15)) {
        moe_tables(F);
        const int T = ((const LAS int*)(F.lds + TILE_OFF))[320 + 64];
        pg8::Gemm g{D, D, D}; SchedDown S{F.vcu, T, F.lds, (const char*)(ws + WS_H), (const char*)(ws + WS_WD)};
        pg8::EpiBf16 E{(bf16*)(ws + WS_Y), D, I.p[25], D, 1.0f};
        pg8::gemm_phase<pg8::EpiBf16, SchedDown, true, false>(ring, F.lds, g, S, E);
    } SEAM(15);
    if (IN(16)) { moe_tables(F); t6_combine_ln(F, I, args.out); }
#undef IN
#undef SEAM
}
#ifndef DBG_CUT
#define DBG_CUT 0
#endif
#if DBG_CUT
namespace v0 {
constexpr int NB = 8, SEQ = 2048, DM = 1024, NTOK = NB * SEQ, MEMT = 256, DIN = 2304, NE = 32, TOPK = 4, CAP = NTOK;
constexpr float ALPHA = 1.189207115002721f;
constexpr float LN_EPS = 1e-5f, RMS_EPS = 1e-6f;
constexpr float LAMBDA_INIT = 0.2f;

__device__ __forceinline__ float wave_sum(float v) {
#pragma unroll
    for (int o = 1; o < 64; o <<= 1) v += __shfl_xor(v, o);
    return v;
}
__device__ __forceinline__ float wave_max(float v) {
#pragma unroll
    for (int o = 1; o < 64; o <<= 1) v = fmaxf(v, __shfl_xor(v, o));
    return v;
}

struct GemmArgs {
    const float* A; const float* B; const float* B2; float* C;
    const float* bias; const float* bias2; const float* R;
    const int* rowidx; const int* Mdev; const int* offdev; const float* gate;
    float alpha;
    int M, N, K, lda, ldb, ldc, transB, nz2, aoff_dev, coff_dev;
    long a1, a2, b1, b2, c1, c2, bias1, idx1;
};

template <int MODE>
__global__ void __launch_bounds__(256) k_gemm(GemmArgs g) {
    __shared__ float As[16][68];
    __shared__ float Bs[16][68];
    __shared__ float Bs2[MODE == 2 ? 16 : 1][68];
    const int z = blockIdx.z, z1 = z / g.nz2, z2 = z % g.nz2;
    const int M = g.Mdev ? g.Mdev[z] : g.M;
    const int m0 = blockIdx.y * 64, n0 = blockIdx.x * 64;
    if (m0 >= M) return;
    const float* A = g.A + z1 * g.a1 + z2 * g.a2;
    const float* B = g.B + z1 * g.b1 + z2 * g.b2;
    const float* B2 = MODE == 2 ? g.B2 + z1 * g.b1 + z2 * g.b2 : nullptr;
    float* C = g.C + z1 * g.c1 + z2 * g.c2;
    const long doff = g.offdev ? (long)g.offdev[z] : 0;
    const long aoff = g.aoff_dev ? doff : 0, coff = g.coff_dev ? doff : 0;
    const int* idx = g.rowidx ? g.rowidx + (long)z * g.idx1 : nullptr;
    const int tid = threadIdx.x, tx = tid & 15, ty = tid >> 4;
    float acc[4][4], acc2[4][4];
#pragma unroll
    for (int i = 0; i < 4; ++i)
#pragma unroll
        for (int j = 0; j < 4; ++j) { acc[i][j] = 0.f; acc2[i][j] = 0.f; }
    for (int k0 = 0; k0 < g.K; k0 += 16) {
        {
            const int r = tid >> 2, kq = (tid & 3) * 4, m = m0 + r;
            float4 v = make_float4(0.f, 0.f, 0.f, 0.f);
            if (m < M) { const long row = (idx && MODE != 3) ? (long)idx[m] : (aoff + m); v = *(const float4*)(A + row * g.lda + k0 + kq); }
            As[kq + 0][r] = v.x; As[kq + 1][r] = v.y; As[kq + 2][r] = v.z; As[kq + 3][r] = v.w;
        }
        if (g.transB) {
            const int n = tid >> 2, kq = (tid & 3) * 4;
            float4 v = make_float4(0.f, 0.f, 0.f, 0.f);
            if (n0 + n < g.N) v = *(const float4*)(B + (long)(n0 + n) * g.ldb + k0 + kq);
            Bs[kq + 0][n] = v.x; Bs[kq + 1][n] = v.y; Bs[kq + 2][n] = v.z; Bs[kq + 3][n] = v.w;
        } else {
            const int k = tid >> 4, nq = (tid & 15) * 4;
            float4 v = make_float4(0.f, 0.f, 0.f, 0.f);
            if (n0 + nq < g.N) v = *(const float4*)(B + (long)(k0 + k) * g.ldb + n0 + nq);
            Bs[k][nq + 0] = v.x; Bs[k][nq + 1] = v.y; Bs[k][nq + 2] = v.z; Bs[k][nq + 3] = v.w;
            if (MODE == 2) {
                float4 w = *(const float4*)(B2 + (long)(k0 + k) * g.ldb + n0 + nq);
                Bs2[k][nq + 0] = w.x; Bs2[k][nq + 1] = w.y; Bs2[k][nq + 2] = w.z; Bs2[k][nq + 3] = w.w;
            }
        }
        __syncthreads();
#pragma unroll
        for (int kk = 0; kk < 16; ++kk) {
            float a[4], b[4], b2[4];
#pragma unroll
            for (int i = 0; i < 4; ++i) a[i] = As[kk][ty * 4 + i];
#pragma unroll
            for (int j = 0; j < 4; ++j) b[j] = Bs[kk][tx * 4 + j];
            if (MODE == 2) {
#pragma unroll
                for (int j = 0; j < 4; ++j) b2[j] = Bs2[kk][tx * 4 + j];
            }
#pragma unroll
            for (int i = 0; i < 4; ++i)
#pragma unroll
                for (int j = 0; j < 4; ++j) { acc[i][j] += a[i] * b[j]; if (MODE == 2) acc2[i][j] += a[i] * b2[j]; }
        }
        __syncthreads();
    }
    const float* bias = g.bias ? g.bias + (long)z * g.bias1 : nullptr;
    const float* bias2 = (MODE == 2 && g.bias2) ? g.bias2 + (long)z * g.bias1 : nullptr;
#pragma unroll
    for (int i = 0; i < 4; ++i) {
        const int m = m0 + ty * 4 + i;
        if (m >= M) continue;
#pragma unroll
        for (int j = 0; j < 4; ++j) {
            const int n = n0 + tx * 4 + j;
            if (n >= g.N) continue;
            float v = acc[i][j] + (bias ? bias[n] : 0.f);
            if (MODE == 0) { C[(coff + m) * g.ldc + n] = v; }
            else if (MODE == 1) { C[(coff + m) * g.ldc + n] = g.alpha * g.R[(long)m * g.ldc + n] + v; }
            else if (MODE == 2) {
                float gg = fminf(v, 7.0f);
                float uu = acc2[i][j] + (bias2 ? bias2[n] : 0.f);
                uu = fminf(fmaxf(uu, -7.0f), 7.0f);
                const float sg = 1.0f / (1.0f + expf(-1.702f * gg));
                C[(coff + m) * g.ldc + n] = gg * sg * (uu + 1.0f);
            } else if (MODE == 3) {
                const int tok = idx[m];
                const float gt = g.gate[(long)z * g.idx1 + m];
                atomicAdd(&C[(long)tok * g.ldc + n], gt * v);
            } else { C[(coff + m) * g.ldc + n] = v * g.alpha; }
        }
    }
}

__global__ void __launch_bounds__(256) k_norm_rope(const float* __restrict__ h, const float* __restrict__ gq, const float* __restrict__ gk,
                                                   float* QA, float* KA, float* QB, float* KB) {
    const int lane = threadIdx.x & 63, w = threadIdx.x >> 6;
    const long item = (long)blockIdx.x * 4 + w;
    if (item >= (long)NTOK * 26) return;
    const int t = (int)(item / 26), slot = (int)(item % 26), s = t % SEQ;
    const float* hr = h + (long)t * DIN;
    if (slot < 10) {
        const bool isq = slot < 8;
        const int col0 = isq ? slot * 64 : 512 + (slot - 8) * 64;
        const float v = hr[col0 + lane];
        const float ss = wave_sum(v * v);
        const float y = v * (1.0f / sqrtf(ss * (1.0f / 64.0f) + RMS_EPS)) * (isq ? gq[lane] : gk[lane]);
        const int sub = lane >> 5, j = lane & 31, i = j & 15;
        const int pos = sub == 0 ? (s >> 6) : (s & 63);
        const float inv = powf(10000.0f, -(float)(2 * i) / 32.0f);
        const float ang = (float)pos * inv;
        const float c = cosf(ang), sn = sinf(ang);
        const float p = __shfl_xor(y, 16);
        const float o = (j < 16) ? (y * c - p * sn) : (y * c + p * sn);
        if (isq) QA[(long)t * 512 + slot * 64 + lane] = o; else KA[(long)t * 128 + (slot - 8) * 64 + lane] = o;
    } else {
        const bool isq = slot < 18;
        const int hc = isq ? slot - 10 : slot - 18;
        const int col0 = (isq ? 768 : 1280) + hc * 64;
        const float v = hr[col0 + lane];
        const int i = lane & 31;
        const float inv = powf(10000.0f, -(float)(2 * i) / 64.0f);
        const float ang = (float)s * inv;
        const float c = cosf(ang), sn = sinf(ang);
        const float p = __shfl_xor(v, 32);
        const float o = (lane < 32) ? (v * c - p * sn) : (v * c + p * sn);
        if (isq) QB[(long)t * 512 + hc * 64 + lane] = o; else KB[(long)t * 512 + hc * 64 + lane] = o;
    }
}

template <int DV>
__global__ void __launch_bounds__(64) k_attn(const float* __restrict__ Q, int ldq, const float* __restrict__ K, int ldk, int kgroup,
                                             const float* __restrict__ V, int ldv, int vgroup, int vstride, float* O, int diffmode, float scale) {
    __shared__ float Ks[32][64];
    __shared__ float Vs[32][DV];
    const int lane = threadIdx.x, y = blockIdx.y, b = blockIdx.z;
    const long t = (long)b * SEQ + blockIdx.x * 64 + lane;
    const float* qp = Q + t * ldq + y * 64;
    const float* kb = K + (long)b * SEQ * ldk + (y / kgroup) * 64;
    const float* vb = V + (long)b * SEQ * ldv + (y / vgroup) * vstride;
    float q[64], o[DV];
#pragma unroll
    for (int d = 0; d < 64; d += 4) { const float4 v = *(const float4*)(qp + d); q[d] = v.x * scale; q[d + 1] = v.y * scale; q[d + 2] = v.z * scale; q[d + 3] = v.w * scale; }
#pragma unroll
    for (int d = 0; d < DV; ++d) o[d] = 0.f;
    float m = -INFINITY, l = 0.f;
    for (int kt = 0; kt < SEQ; kt += 32) {
        __syncthreads();
#pragma unroll
        for (int i = 0; i < 8; ++i) { const int e = i * 64 + lane, r = e >> 4, c4 = (e & 15) * 4; *(float4*)&Ks[r][c4] = *(const float4*)(kb + (long)(kt + r) * ldk + c4); }
#pragma unroll
        for (int i = 0; i < DV / 8; ++i) { const int e = i * 64 + lane, r = e / (DV / 4), c4 = (e % (DV / 4)) * 4; *(float4*)&Vs[r][c4] = *(const float4*)(vb + (long)(kt + r) * ldv + c4); }
        __syncthreads();
        for (int j = 0; j < 32; ++j) {
            float s = 0.f;
#pragma unroll
            for (int d = 0; d < 64; d += 4) { const float4 kv = *(const float4*)&Ks[j][d]; s += q[d] * kv.x + q[d + 1] * kv.y + q[d + 2] * kv.z + q[d + 3] * kv.w; }
            const float mn = fmaxf(m, s);
            const float corr = expf(m - mn), p = expf(s - mn);
            l = l * corr + p; m = mn;
#pragma unroll
            for (int d = 0; d < DV; d += 4) { const float4 vv = *(const float4*)&Vs[j][d];
                o[d] = o[d] * corr + p * vv.x; o[d + 1] = o[d + 1] * corr + p * vv.y; o[d + 2] = o[d + 2] * corr + p * vv.z; o[d + 3] = o[d + 3] * corr + p * vv.w; }
        }
    }
    const float rl = 1.0f / l;
    float* op;
    if (diffmode) op = O + (long)(y & 1) * ((long)NTOK * 512) + t * 512 + (y >> 1) * 128;
    else op = O + t * 1024 + y * 64;
#pragma unroll
    for (int d = 0; d < DV; d += 4) *(float4*)(op + d) = make_float4(o[d] * rl, o[d + 1] * rl, o[d + 2] * rl, o[d + 3] * rl);
}

__global__ void __launch_bounds__(256) k_diff_combine(const float* __restrict__ OT, const float* lq1, const float* lk1, const float* lq2, const float* lk2,
                                                      const float* __restrict__ subg, float* AO) {
    const int lane = threadIdx.x & 63, w = threadIdx.x >> 6;
    const long item = (long)blockIdx.x * 4 + w;
    if (item >= (long)NTOK * 4) return;
    const float lam = expf(wave_sum(lq1[lane] * lk1[lane])) - expf(wave_sum(lq2[lane] * lk2[lane])) + LAMBDA_INIT;
    const int t = (int)(item >> 2), hh = (int)(item & 3);
    const float* o1 = OT + (long)t * 512 + hh * 128;
    const float* o2 = o1 + (long)NTOK * 512;
    const float v0 = o1[lane] - lam * o2[lane], v1 = o1[lane + 64] - lam * o2[lane + 64];
    const float ss = wave_sum(v0 * v0 + v1 * v1);
    const float r = 1.0f / sqrtf(ss * (1.0f / 128.0f) + RMS_EPS);
    float* out = AO + (long)t * 1024 + 512 + hh * 128;
    out[lane] = v0 * r * subg[lane] * (1.0f - LAMBDA_INIT);
    out[lane + 64] = v1 * r * subg[lane + 64] * (1.0f - LAMBDA_INIT);
}

__global__ void __launch_bounds__(256) k_ln(const float* in, const float* __restrict__ g, const float* __restrict__ bta, float* out, float* out2, float a2, int rows) {
    const int lane = threadIdx.x & 63, w = threadIdx.x >> 6;
    const int row = blockIdx.x * 4 + w;
    if (row >= rows) return;
    const float4* xr = (const float4*)(in + (long)row * DM) + lane;
    float4 v[4]; float s = 0.f;
#pragma unroll
    for (int j = 0; j < 4; ++j) { v[j] = xr[64 * j]; s += (v[j].x + v[j].y) + (v[j].z + v[j].w); }
    const float mean = wave_sum(s) * (1.0f / DM); float s2 = 0.f;
#pragma unroll
    for (int j = 0; j < 4; ++j) { v[j].x -= mean; v[j].y -= mean; v[j].z -= mean; v[j].w -= mean; s2 += (v[j].x * v[j].x + v[j].y * v[j].y) + (v[j].z * v[j].z + v[j].w * v[j].w); }
    const float rstd = 1.0f / sqrtf(wave_sum(s2) * (1.0f / DM) + LN_EPS);
#pragma unroll
    for (int j = 0; j < 4; ++j) {
        const float4 gg = ((const float4*)g)[lane + 64 * j], bb = ((const float4*)bta)[lane + 64 * j];
        float4 o; o.x = v[j].x * rstd * gg.x + bb.x; o.y = v[j].y * rstd * gg.y + bb.y; o.z = v[j].z * rstd * gg.z + bb.z; o.w = v[j].w * rstd * gg.w + bb.w;
        ((float4*)(out + (long)row * DM))[lane + 64 * j] = o;
        if (out2) ((float4*)(out2 + (long)row * DM))[lane + 64 * j] = make_float4(a2 * o.x, a2 * o.y, a2 * o.z, a2 * o.w);
    }
}

__global__ void __launch_bounds__(256) k_softmax256(float* S, long nrows) {
    const int lane = threadIdx.x & 63, w = threadIdx.x >> 6;
    const long row = (long)blockIdx.x * 4 + w;
    if (row >= nrows) return;
    float4* p = (float4*)(S + row * 256) + lane;
    float4 v = *p;
    const float mx = wave_max(fmaxf(fmaxf(v.x, v.y), fmaxf(v.z, v.w)));
    v.x = expf(v.x - mx); v.y = expf(v.y - mx); v.z = expf(v.z - mx); v.w = expf(v.w - mx);
    const float r = 1.0f / wave_sum((v.x + v.y) + (v.z + v.w));
    v.x *= r; v.y *= r; v.z *= r; v.w *= r;
    *p = v;
}

__global__ void __launch_bounds__(256) k_topk(const float* __restrict__ logits, int* cnt, int* list, float* glist) {
    const int t = blockIdx.x * 256 + threadIdx.x;
    if (t >= NTOK) return;
    float lg[NE];
#pragma unroll
    for (int e = 0; e < NE; e += 4) { const float4 v = *(const float4*)(logits + (long)t * NE + e); lg[e] = v.x; lg[e + 1] = v.y; lg[e + 2] = v.z; lg[e + 3] = v.w; }
    int sel[TOPK]; float sv[TOPK];
#pragma unroll
    for (int k = 0; k < TOPK; ++k) {
        float best = -INFINITY; int bi = 0;
#pragma unroll
        for (int e = 0; e < NE; ++e) { const bool taken = (k > 0 && sel[0] == e) || (k > 1 && sel[1] == e) || (k > 2 && sel[2] == e); if (!taken && lg[e] > best) { best = lg[e]; bi = e; } }
        sel[k] = bi; sv[k] = best;
    }
    const float mx = sv[0];
    float ex[TOPK], sum = 0.f;
#pragma unroll
    for (int k = 0; k < TOPK; ++k) { ex[k] = expf(sv[k] - mx); sum += ex[k]; }
#pragma unroll
    for (int k = 0; k < TOPK; ++k) {
        const int pos = atomicAdd(&cnt[sel[k]], 1);
        list[(long)sel[k] * CAP + pos] = t;
        glist[(long)sel[k] * CAP + pos] = ex[k] / sum;
    }
}
__global__ void k_offsets(const int* cnt, int* off) {
    if (threadIdx.x == 0 && blockIdx.x == 0) { int a = 0; for (int e = 0; e < NE; ++e) { off[e] = a; a += cnt[e]; } }
}
}
#endif

#ifndef DBG_CUT
#define DBG_CUT 0
#endif
#ifndef MK_SPLIT
#define MK_SPLIT 0
#endif

#if DBG_CUT
__global__ void __launch_bounds__(256) k_bf16_to_f32(const unsigned short* in, float* out, long n) {
    const long i = (long)blockIdx.x * 256 + threadIdx.x; if (i < n) out[i] = __uint_as_float((unsigned)in[i] << 16);
}
__global__ void __launch_bounds__(256) k_scale(const float* in, float* out, float a, long n) {
    const long i = (long)blockIdx.x * 256 + threadIdx.x; if (i < n) out[i] = a * in[i];
}
static void v0_tail(int stage, void* const* d_in, float* out, char* ws, hipStream_t stream) {
    using namespace v0;
    constexpr size_t MiB = 1u << 20;
    const float* x = (const float*)d_in[0]; const float* mem = (const float*)d_in[1];
    const float* w_mix = (const float*)d_in[10]; const float* ln1g = (const float*)d_in[11]; const float* ln1b = (const float*)d_in[12];
    const float* w_mq = (const float*)d_in[13]; const float* w_mkv = (const float*)d_in[14]; const float* w_mo = (const float*)d_in[15];
    const float* ln2g = (const float*)d_in[16]; const float* ln2b = (const float*)d_in[17]; const float* w_r = (const float*)d_in[18]; const float* b_r = (const float*)d_in[19];
    const float* w_g = (const float*)d_in[20]; const float* b_g = (const float*)d_in[21]; const float* w_u = (const float*)d_in[22]; const float* b_u = (const float*)d_in[23];
    const float* w_d = (const float*)d_in[24]; const float* b_d = (const float*)d_in[25]; const float* ln3g = (const float*)d_in[26]; const float* ln3b = (const float*)d_in[27];
    float* X1 = (float*)(ws + 0); float* QM = (float*)(ws + 64 * MiB); float* AOf = QM; float* S = (float*)(ws + 128 * MiB); float* XO = (float*)(ws + 192 * MiB);
    float* KV = (float*)(ws + 392 * MiB); float* X2 = (float*)(ws + 448 * MiB); float* Y = (float*)(ws + 256 * MiB); float* HH = (float*)(ws + 0);
    int* cnt = (int*)(ws + 320 * MiB); int* off = cnt + 64; float* logits = (float*)(ws + 321 * MiB); int* list = (int*)(ws + 323 * MiB); float* glist = (float*)(ws + 325 * MiB);
    (void)hipMemsetAsync(cnt, 0, 1024, stream);
    auto gemm0 = [&](int mode, GemmArgs g, dim3 grid) {
        switch (mode) {
            case 0: hipLaunchKernelGGL(k_gemm<0>, grid, dim3(256), 0, stream, g); break;
            case 1: hipLaunchKernelGGL(k_gemm<1>, grid, dim3(256), 0, stream, g); break;
            case 2: hipLaunchKernelGGL(k_gemm<2>, grid, dim3(256), 0, stream, g); break;
            case 3: hipLaunchKernelGGL(k_gemm<3>, grid, dim3(256), 0, stream, g); break;
            default: hipLaunchKernelGGL(k_gemm<4>, grid, dim3(256), 0, stream, g); break;
        }
    };
    if (stage <= 1) {
        { GemmArgs g{}; g.A = AOf; g.B = w_mix; g.C = X1; g.R = x; g.alpha = ALPHA; g.M = NTOK; g.N = DM; g.K = DM; g.lda = DM; g.ldb = DM; g.ldc = DM; g.nz2 = 1; gemm0(1, g, dim3(DM / 64, NTOK / 64, 1)); }
        hipLaunchKernelGGL(k_ln, dim3(NTOK / 4), dim3(256), 0, stream, X1, ln1g, ln1b, X1, (float*)nullptr, 0.f, NTOK);
    }
    if (stage <= 2) {
        { GemmArgs g{}; g.A = mem; g.B = w_mkv; g.C = KV; g.M = NB * MEMT; g.N = 2048; g.K = DM; g.lda = DM; g.ldb = 2048; g.ldc = 2048; g.nz2 = 1; gemm0(0, g, dim3(2048 / 64, NB * MEMT / 64, 1)); }
        { GemmArgs g{}; g.A = X1; g.B = w_mq; g.C = QM; g.M = NTOK; g.N = DM; g.K = DM; g.lda = DM; g.ldb = DM; g.ldc = DM; g.nz2 = 1; gemm0(0, g, dim3(DM / 64, NTOK / 64, 1)); }
        { GemmArgs g{}; g.A = QM; g.B = KV; g.C = S; g.alpha = 0.0625f; g.M = SEQ; g.N = 256; g.K = 256; g.lda = DM; g.ldb = 2048; g.ldc = DM; g.transB = 1; g.nz2 = 4;
          g.a1 = (long)SEQ * DM; g.a2 = 256; g.b1 = (long)MEMT * 2048; g.b2 = 256; g.c1 = (long)SEQ * DM; g.c2 = 256; gemm0(4, g, dim3(4, SEQ / 64, NB * 4)); }
        hipLaunchKernelGGL(k_softmax256, dim3(NTOK * 4 / 4), dim3(256), 0, stream, S, (long)NTOK * 4);
        { GemmArgs g{}; g.A = S; g.B = KV + 1024; g.C = XO; g.M = SEQ; g.N = 256; g.K = 256; g.lda = DM; g.ldb = 2048; g.ldc = DM; g.nz2 = 4;
          g.a1 = (long)SEQ * DM; g.a2 = 256; g.b1 = (long)MEMT * 2048; g.b2 = 256; g.c1 = (long)SEQ * DM; g.c2 = 256; gemm0(0, g, dim3(4, SEQ / 64, NB * 4)); }
        { GemmArgs g{}; g.A = XO; g.B = w_mo; g.C = X2; g.R = X1; g.alpha = ALPHA; g.M = NTOK; g.N = DM; g.K = DM; g.lda = DM; g.ldb = DM; g.ldc = DM; g.nz2 = 1; gemm0(1, g, dim3(DM / 64, NTOK / 64, 1)); }
        hipLaunchKernelGGL(k_ln, dim3(NTOK / 4), dim3(256), 0, stream, X2, ln2g, ln2b, X2, Y, ALPHA, NTOK);
    } else {
        hipLaunchKernelGGL(k_scale, dim3(NTOK * DM / 256), dim3(256), 0, stream, X2, Y, ALPHA, (long)NTOK * DM);
    }
    { GemmArgs g{}; g.A = X2; g.B = w_r; g.C = logits; g.bias = b_r; g.M = NTOK; g.N = NE; g.K = DM; g.lda = DM; g.ldb = NE; g.ldc = NE; g.nz2 = 1; gemm0(0, g, dim3(1, NTOK / 64, 1)); }
    hipLaunchKernelGGL(k_topk, dim3(NTOK / 256), dim3(256), 0, stream, logits, cnt, list, glist);
    hipLaunchKernelGGL(k_offsets, dim3(1), dim3(64), 0, stream, cnt, off);
    { GemmArgs g{}; g.A = X2; g.B = w_g; g.B2 = w_u; g.C = HH; g.bias = b_g; g.bias2 = b_u; g.rowidx = list; g.Mdev = cnt; g.offdev = off; g.coff_dev = 1;
      g.M = NTOK; g.N = DM; g.K = DM; g.lda = DM; g.ldb = DM; g.ldc = DM; g.nz2 = 1; g.b1 = (long)DM * DM; g.bias1 = DM; g.idx1 = CAP; gemm0(2, g, dim3(DM / 64, NTOK / 64, NE)); }
    { GemmArgs g{}; g.A = HH; g.B = w_d; g.C = Y; g.bias = b_d; g.rowidx = list; g.Mdev = cnt; g.offdev = off; g.aoff_dev = 1; g.gate = glist;
      g.M = NTOK; g.N = DM; g.K = DM; g.lda = DM; g.ldb = DM; g.ldc = DM; g.nz2 = 1; g.b1 = (long)DM * DM; g.bias1 = DM; g.idx1 = CAP; gemm0(3, g, dim3(DM / 64, NTOK / 64, NE)); }
    hipLaunchKernelGGL(k_ln, dim3(NTOK / 4), dim3(256), 0, stream, Y, ln3g, ln3b, out, (float*)nullptr, 0.f, NTOK);
}
#endif

extern "C" void kernel_launch(void* const* d_in, const int* in_sizes, int n_in, void* d_out, int out_size, void* d_ws, size_t ws_size, hipStream_t stream) {
    static int grid = 0;
    if (grid == 0) {
        if (n_in != 28 || in_sizes[0] != M * D || out_size != M * D || ws_size < WS_END) { fprintf(stderr, "kernel_launch: unexpected shapes (n_in %d, in0 %d, out %d, ws %zu); nothing launched\n", n_in, n_in > 0 ? in_sizes[0] : -1, out_size, ws_size); grid = -1; return; }
        int dev = 0, cus = 0, per_cu = 0;
        if (hipGetDevice(&dev) != hipSuccess || hipDeviceGetAttribute(&cus, hipDeviceAttributeMultiprocessorCount, dev) != hipSuccess) { grid = -1; return; }
        if (hipFuncSetAttribute((const void*)mk_fwd, hipFuncAttributeMaxDynamicSharedMemorySize, LDS_BYTES) != hipSuccess) { fprintf(stderr, "kernel_launch: hipFuncSetAttribute failed\n"); grid = -1; return; }
        if (hipOccupancyMaxActiveBlocksPerMultiprocessor(&per_cu, (const void*)mk_fwd, NWAVES * 64, LDS_BYTES) != hipSuccess || per_cu < 1) { fprintf(stderr, "kernel_launch: occupancy query reports %d workgroups per CU\n", per_cu); }
        (void)hipGetLastError();
        grid = cus;
        if (grid != 256) fprintf(stderr, "kernel_launch: %d CUs (built for 256)\n", grid);
    }
    if (grid < 0) return;
    if (hipMemsetAsync((char*)d_ws + WS_CTL, 0, CTL_ZERO_BYTES, stream) != hipSuccess) return;
    Args a{};
    for (int i = 0; i < 28; ++i) a.in[i] = (const float*)d_in[i];
    a.out = (float*)d_out; a.ws = (unsigned char*)d_ws;
#if DBG_CUT == 1
    const int last_phase = 5;
#elif DBG_CUT == 2
    const int last_phase = 7;
#elif DBG_CUT == 3
    const int last_phase = 13;
#else
    const int last_phase = NPHASE;
#endif
#if MK_SPLIT
    for (int p = 0; p < last_phase; ++p) { a.ph_lo = p; a.ph_hi = p + 1; a.li = p; hipLaunchKernelGGL(mk_fwd, dim3(grid), dim3(NWAVES * 64), LDS_BYTES, stream, a); }
#else
    a.ph_lo = 0; a.ph_hi = last_phase; a.li = 0; hipLaunchKernelGGL(mk_fwd, dim3(grid), dim3(NWAVES * 64), LDS_BYTES, stream, a);
#endif
#if DBG_CUT
    {
        char* ws = (char*)d_ws; const size_t MiBh = 1u << 20;
#if DBG_CUT == 1
        hipLaunchKernelGGL(k_bf16_to_f32, dim3(M * D / 256), dim3(256), 0, stream, (const unsigned short*)(ws + WS_AO), (float*)(ws + 64 * MiBh), (long)M * D);
#elif DBG_CUT == 2
        (void)hipMemcpyAsync(ws + 0, ws + WS_X1, (size_t)M * D * 4, hipMemcpyDeviceToDevice, stream);
#else
        (void)hipMemcpyAsync(ws + 448 * MiBh, ws + WS_X2, (size_t)M * D * 4, hipMemcpyDeviceToDevice, stream);
#endif
        v0_tail(DBG_CUT, d_in, (float*)d_out, ws, stream);
    }
#endif
}
```

```cpp
#include <hip/hip_runtime.h>
#include <cstdio>
#include <cstdint>
namespace pg8 {
#define PG8_LAS __attribute__((address_space(3)))
typedef unsigned short bf16_t;
typedef short bf16x8 __attribute__((ext_vector_type(8)));
typedef float f32x4 __attribute__((ext_vector_type(4)));
typedef unsigned u32x4 __attribute__((ext_vector_type(4)));
typedef int i32x4 __attribute__((ext_vector_type(4)));
typedef int i32x8 __attribute__((ext_vector_type(8)));
constexpr int BM = 256, BK = 64, HALF = 128, HTB = HALF * BK * 2  , STAGE_BYTES = 8 * HTB, NXCD = 8, WGM = 8;

__host__ __device__ __forceinline__ int lds_byte(int r, int c) { const int st = (r >> 4) * 2 + (c >> 5), rr = r & 15, cc = c & 31, ob = rr * 64 + cc * 2; return st * 1024 + (ob ^ (((ob >> 9) & 1) << 5)); }
__host__ __device__ __forceinline__ void stage_rc(int b, int& R, int& C) { const int st = b / 1024, sb = b % 1024, swz = sb ^ (((sb >> 9) & 1) << 5); R = (st >> 1) * 16 + swz / 64; C = (st & 1) * 32 + (swz % 64) / 2; }
__host__ __device__ __forceinline__ int perm32(int rho) { const int n = rho >> 4, i = rho & 15; return 8 * (i >> 2) + 4 * n + (i & 3); }
__device__ __forceinline__ unsigned cvt_pk_bf16(float lo, float hi) { unsigned r; asm volatile("v_cvt_pk_bf16_f32 %0, %1, %2" : "=v"(r) : "v"(lo), "v"(hi)); return r; }
typedef float f32x2 __attribute__((ext_vector_type(2)));

struct Unit { const char* A; const char* B; void* O; int ldo, orow, ocol, aux, gidx; };
struct Gemm { int lda, ldb, K; };

struct EpiBf16 {
    static constexpr bool PERM = true, AFTER_DRAIN = false;
    bf16_t* O; int ldc; const float* bias; int bstride; float scale;
    __device__ __forceinline__ void operator()(const f32x4 (&acc)[2][2][4][2], const Unit& u, int wr, int wc, int fr, int fq) const {
        bf16_t* base = O ? O : (bf16_t*)u.O; const int ld = O ? ldc : u.ldo;
        const int row0 = u.orow + wr * 64 + fr, col0 = u.ocol + wc * 32 + 8 * fq;
        f32x4 bv[2][2];
#pragma unroll
        for (int bj = 0; bj < 2; ++bj)
#pragma unroll
            for (int n = 0; n < 2; ++n) bv[bj][n] = bias ? *(const f32x4*)(bias + (size_t)u.aux * bstride + col0 + bj * HALF + 4 * n) : (f32x4){0.f, 0.f, 0.f, 0.f};
#pragma unroll
        for (int ai = 0; ai < 2; ++ai)
#pragma unroll
            for (int m = 0; m < 4; ++m) { bf16_t* rowp = base + (size_t)(row0 + ai * HALF + m * 16) * ld + col0;
#pragma unroll
                for (int bj = 0; bj < 2; ++bj) { f32x4 v0 = acc[ai][bj][m][0] * scale + bv[bj][0], v1 = acc[ai][bj][m][1] * scale + bv[bj][1];
                    u32x4 w; w.x = cvt_pk_bf16(v0[0], v0[1]); w.y = cvt_pk_bf16(v0[2], v0[3]); w.z = cvt_pk_bf16(v1[0], v1[1]); w.w = cvt_pk_bf16(v1[2], v1[3]);
                    *(u32x4*)(rowp + bj * HALF) = w; } }
    }
};
struct EpiF32 {
    static constexpr bool PERM = false, AFTER_DRAIN = false;
    float* out; const float* base; int ldc; float alpha, scale;
    __device__ __forceinline__ void operator()(const f32x4 (&acc)[2][2][4][2], const Unit& u, int wr, int wc, int fr, int fq) const {
        const int col0 = u.ocol + wc * 32 + 4 * fq;
#pragma unroll
        for (int ai = 0; ai < 2; ++ai)
#pragma unroll
            for (int m = 0; m < 4; ++m) { const size_t off = (size_t)(u.orow + ai * HALF + wr * 64 + m * 16 + fr) * ldc + col0;
#pragma unroll
                for (int bj = 0; bj < 2; ++bj)
#pragma unroll
                    for (int n = 0; n < 2; ++n) { f32x4 o = acc[ai][bj][m][n] * scale;
                        if (base) { const f32x4 bs = *(const f32x4*)(base + off + bj * HALF + n * 16); o = o + bs * alpha; }
                        *(f32x4*)(out + off + bj * HALF + n * 16) = o; }
                if (m & 1) asm volatile("" ::: "memory"); }
    }
};
struct EpiSwiglu {
    static constexpr bool PERM = true, AFTER_DRAIN = false;
    unsigned char* H; int ldc; const float* bg; const float* bu; float ascale;
    __device__ __forceinline__ static float act(float g, float u) {
        g = fminf(g, 7.0f); u = fminf(fmaxf(u, -7.0f), 7.0f);
        const float sg = __builtin_amdgcn_rcpf(1.0f + __builtin_amdgcn_exp2f(-1.702f * 1.4426950408889634f * g));
        return g * sg * (u + 1.0f);
    }
    __device__ __forceinline__ void operator()(const f32x4 (&acc)[2][2][4][2], const Unit& u, int wr, int wc, int fr, int fq) const {
        const int row0 = u.orow + wr * 64 + fr, col0 = u.ocol + wc * 32 + 8 * fq;
        f32x4 bgv[2], buv[2];
#pragma unroll
        for (int n = 0; n < 2; ++n) { bgv[n] = *(const f32x4*)(bg + (size_t)u.aux * 1024 + col0 + 4 * n); buv[n] = *(const f32x4*)(bu + (size_t)u.aux * 1024 + col0 + 4 * n); }
#pragma unroll
        for (int ai = 0; ai < 2; ++ai)
#pragma unroll
            for (int m = 0; m < 4; ++m) { unsigned char* rowp = H + (size_t)(row0 + ai * HALF + m * 16) * ldc + col0;
                const f32x4 g0 = acc[ai][0][m][0] * ascale + bgv[0], g1 = acc[ai][0][m][1] * ascale + bgv[1], u0 = acc[ai][1][m][0] * ascale + buv[0], u1 = acc[ai][1][m][1] * ascale + buv[1];
                unsigned w0 = 0u, w1 = 0u;
                w0 = __builtin_amdgcn_cvt_pk_fp8_f32(act(g0[0], u0[0]), act(g0[1], u0[1]), w0, false); w0 = __builtin_amdgcn_cvt_pk_fp8_f32(act(g0[2], u0[2]), act(g0[3], u0[3]), w0, true);
                w1 = __builtin_amdgcn_cvt_pk_fp8_f32(act(g1[0], u1[0]), act(g1[1], u1[1]), w1, false); w1 = __builtin_amdgcn_cvt_pk_fp8_f32(act(g1[2], u1[2]), act(g1[3], u1[3]), w1, true);
                typedef unsigned u32x2 __attribute__((ext_vector_type(2))); *(u32x2*)rowp = (u32x2){w0, w1}; }
    }
};

__device__ __forceinline__ const char* rfl_ptr(const char* p) { const unsigned long long v = (unsigned long long)p; const unsigned lo = __builtin_amdgcn_readfirstlane((unsigned)v), hi = __builtin_amdgcn_readfirstlane((unsigned)(v >> 32)); return (const char*)(((unsigned long long)hi << 32) | lo); }
template <class Epi, class Sched, bool ALIGN_EPI, bool GATHER, bool FP8 = false>
__device__ __forceinline__ void gemm_phase(PG8_LAS unsigned char* lds, PG8_LAS unsigned char* ldsall, const Gemm g, const Sched& S, const Epi& E) {
    const int tid = threadIdx.x, wid = __builtin_amdgcn_readfirstlane(tid >> 6), lane = tid & 63, wr = wid >> 2, wc = wid & 3, fr = lane & 15, fq = lane >> 4;
    const int K = g.K, nt = K / 128;
    unsigned voffA[2], voffB[2];
#pragma unroll
    for (int i = 0; i < 2; ++i) { int R, C; stage_rc(tid * 16 + i * 8192, R, C); const int Rb = Epi::PERM ? ((R & ~31) + perm32(R & 31)) : R;
        voffA[i] = (unsigned)(R * g.lda + C * 2); voffB[i] = (unsigned)(Rb * g.ldb + C * 2); }
    const size_t kstep = (size_t)128;
    const size_t hstepA = (size_t)HALF * g.lda, hstepB = (size_t)HALF * g.ldb;
    const unsigned ldsw = (unsigned)wid * 1024u;
    const int aoff = lds_byte(wr * 64 + fr, fq * 8), boff = lds_byte(wc * 32 + fr, fq * 8);
    const unsigned lda2 = (unsigned)g.lda;
#define PG8_SA(b, h) (((b) * 2 + (h)) * HTB)
#define PG8_SB(b, h) ((4 + (b) * 2 + (h)) * HTB)
#define PG8_GL(bufoff, base, off32, i_) do { unsigned _o = (off32); const char* _b = (const char*)(base); asm volatile("" : "+v"(_o), "+s"(_b)); __builtin_amdgcn_global_load_lds((const unsigned*)(_b + _o), (PG8_LAS unsigned*)(lds + (bufoff) + ldsw + (i_) * 8192), 16, 0, 0); } while (0)
#define PG8_STAGE_B(bufoff, gbase) do { _Pragma("unroll") for (int _i = 0; _i < 2; ++_i) PG8_GL(bufoff, gbase, voffB[_i], _i); } while (0)
#define PG8_STAGE_A(bufoff, gbase, h, OFFS) do { _Pragma("unroll") for (int _i = 0; _i < 2; ++_i) { \
        if constexpr (GATHER) PG8_GL(bufoff, gbase, OFFS(h, _i), _i); else PG8_GL(bufoff, (const char*)(gbase) + (h) * hstepA, voffA[_i], _i); } } while (0)
#define PG8_OC(h, i) gA[h][i]
#define PG8_ON(h, i) gA[h][i]
#define PG8_RD8(p) __builtin_shufflevector(*(const PG8_LAS i32x4*)(p), *(const PG8_LAS i32x4*)((p) + 1024), 0, 1, 2, 3, 4, 5, 6, 7)
#define PG8_LDA(dst, b, h) do { _Pragma("unroll") for (int m = 0; m < 4; ++m) { if constexpr (FP8) dst##8[m] = PG8_RD8(lds + PG8_SA(b, h) + aoff + m * 2048); else { _Pragma("unroll") for (int k = 0; k < 2; ++k) dst[m][k] = *(const PG8_LAS bf16x8*)(lds + PG8_SA(b, h) + aoff + m * 2048 + k * 1024); } } } while (0)
#define PG8_LDB(dst, b, h) do { _Pragma("unroll") for (int n = 0; n < 2; ++n) { if constexpr (FP8) dst##8[n] = PG8_RD8(lds + PG8_SB(b, h) + boff + n * 2048); else { _Pragma("unroll") for (int k = 0; k < 2; ++k) dst[n][k] = *(const PG8_LAS bf16x8*)(lds + PG8_SB(b, h) + boff + n * 2048 + k * 1024); } } } while (0)
#define PG8_MMA(ai, bj, At, Bt) do { __builtin_amdgcn_s_setprio(1); _Pragma("unroll") for (int m = 0; m < 4; ++m) _Pragma("unroll") for (int n = 0; n < 2; ++n) { \
        if constexpr (FP8) acc[ai][bj][m][n] = __builtin_amdgcn_mfma_scale_f32_16x16x128_f8f6f4(Bt##8[n], At##8[m], acc[ai][bj][m][n], 0, 0, 0, 0x7f7f7f7f, 0, 0x7f7f7f7f); \
        else { _Pragma("unroll") for (int k = 0; k < 2; ++k) acc[ai][bj][m][n] = __builtin_amdgcn_mfma_f32_16x16x32_bf16(Bt[n][k], At[m][k], acc[ai][bj][m][n], 0, 0, 0); } } __builtin_amdgcn_s_setprio(0); } while (0)
#define PG8_WAIT_V(n) asm volatile("s_waitcnt vmcnt(" #n ")" ::: "memory")
#define PG8_WAIT_L(n) asm volatile("s_waitcnt lgkmcnt(" #n ")" ::: "memory")
#define PG8_BAR __builtin_amdgcn_s_barrier()
#define PG8_SCHED __builtin_amdgcn_sched_barrier(0)
#define PG8_GIDX(dst, un) do { if constexpr (GATHER) { const PG8_LAS int* _ix = (const PG8_LAS int*)(ldsall + (un).gidx); _Pragma("unroll") for (int _h = 0; _h < 2; ++_h) _Pragma("unroll") for (int _i = 0; _i < 2; ++_i) { \
        int _R, _C; stage_rc(tid * 16 + _i * 8192, _R, _C); dst[_h][_i] = (unsigned)_ix[_h * HALF + _R] * lda2 + (unsigned)(_C * 2); } } } while (0)
    Unit cur, nxt; int ui = 0;
    if (!S.next(0, cur)) return;
    f32x4 acc[2][2][4][2];
#pragma unroll
    for (int a = 0; a < 2; ++a)
#pragma unroll
        for (int b = 0; b < 2; ++b)
#pragma unroll
            for (int m = 0; m < 4; ++m)
#pragma unroll
                for (int n = 0; n < 2; ++n) acc[a][b][m][n] = (f32x4){0.f, 0.f, 0.f, 0.f};
    bf16x8 At[4][2], B0[2][2], B1[2][2]; i32x8 At8[4], B08[2], B18[2];
    unsigned gA[2][2] = {{0u, 0u}, {0u, 0u}};
    PG8_GIDX(gA, cur);
    const char* cA = rfl_ptr(cur.A); const char* cB = rfl_ptr(cur.B);
    PG8_STAGE_B(PG8_SB(0, 0), cB); PG8_STAGE_B(PG8_SB(0, 1), cB + hstepB); PG8_STAGE_A(PG8_SA(0, 0), cA, 0, PG8_OC); PG8_STAGE_A(PG8_SA(0, 1), cA, 1, PG8_OC);
    if (wr == 1) PG8_BAR;
    PG8_WAIT_V(2); PG8_BAR;
    PG8_STAGE_B(PG8_SB(1, 0), cB + kstep); PG8_STAGE_A(PG8_SA(1, 0), cA + kstep, 0, PG8_OC); PG8_STAGE_B(PG8_SB(1, 1), cB + hstepB + kstep);
    PG8_WAIT_V(6); PG8_BAR;
    for (;;) {
        const bool has_next = S.next(ui + 1, nxt);
        const char* nA = has_next ? rfl_ptr(nxt.A) : cA; const char* nB = has_next ? rfl_ptr(nxt.B) : cB;
#pragma unroll 1
        for (int t = 0; t < nt; t += 2) {
            const bool last = (t == nt - 2);
            const char* a1 = cA + (size_t)(t + 1) * kstep;
            const char* a2 = last ? nA : cA + (size_t)(t + 2) * kstep; const char* b2 = last ? nB : cB + (size_t)(t + 2) * kstep;
            const char* a3 = a2 + kstep; const char* b3 = b2 + kstep;
            PG8_LDB(B0, 0, 0); PG8_LDB(B1, 0, 1); PG8_SCHED; PG8_LDA(At, 0, 0); PG8_STAGE_A(PG8_SA(1, 1), a1, 1, PG8_OC);
            if constexpr (GATHER) { if (last && has_next) { PG8_GIDX(gA, nxt); } }
            PG8_WAIT_V(8); PG8_WAIT_L(0); PG8_BAR; PG8_MMA(0, 0, At, B0); PG8_MMA(0, 1, At, B1); PG8_BAR; PG8_SCHED;
            PG8_LDA(At, 0, 1); PG8_STAGE_B(PG8_SB(0, 0), b2); PG8_STAGE_B(PG8_SB(0, 1), b2 + hstepB); PG8_STAGE_A(PG8_SA(0, 0), a2, 0, PG8_ON);
            PG8_WAIT_V(8); PG8_WAIT_L(0); PG8_BAR; PG8_MMA(1, 0, At, B0); PG8_MMA(1, 1, At, B1); PG8_BAR; PG8_SCHED;
            PG8_LDB(B0, 1, 0); PG8_LDB(B1, 1, 1); PG8_SCHED; PG8_LDA(At, 1, 0); PG8_STAGE_A(PG8_SA(0, 1), a2, 1, PG8_ON);
            PG8_WAIT_V(8); PG8_WAIT_L(0); PG8_BAR; PG8_MMA(0, 0, At, B0); PG8_MMA(0, 1, At, B1); PG8_BAR; PG8_SCHED;
            PG8_LDA(At, 1, 1); PG8_STAGE_B(PG8_SB(1, 0), b3); PG8_STAGE_B(PG8_SB(1, 1), b3 + hstepB); PG8_STAGE_A(PG8_SA(1, 0), a3, 0, PG8_ON);
            PG8_WAIT_V(8); PG8_WAIT_L(0); PG8_BAR; PG8_MMA(1, 0, At, B0); PG8_MMA(1, 1, At, B1); PG8_BAR; PG8_SCHED;
        }
        if constexpr (ALIGN_EPI) { if (wr == 0) PG8_BAR; }
        if constexpr (!Epi::AFTER_DRAIN) { E(acc, cur, wr, wc, fr, fq); }
        if (!has_next) break;
#pragma unroll
        for (int a = 0; a < 2; ++a)
#pragma unroll
            for (int b = 0; b < 2; ++b)
#pragma unroll
                for (int m = 0; m < 4; ++m)
#pragma unroll
                    for (int n = 0; n < 2; ++n) acc[a][b][m][n] = (f32x4){0.f, 0.f, 0.f, 0.f};
        cur = nxt; cA = nA; cB = nB; ++ui;
        if constexpr (ALIGN_EPI) { if (wr == 1) PG8_BAR; }
    }
    PG8_WAIT_V(0);
    if constexpr (!ALIGN_EPI) { if (wr == 0) PG8_BAR; }
    PG8_BAR;
    if constexpr (Epi::AFTER_DRAIN) { E.fused(acc, cur, wr, wc, fr, fq, lds, wid, lane); }
#undef PG8_SA
#undef PG8_SB
#undef PG8_GL
#undef PG8_STAGE_A
#undef PG8_STAGE_B
#undef PG8_LDA
#undef PG8_LDB
#undef PG8_MMA
#undef PG8_RD8
#undef PG8_WAIT_V
#undef PG8_WAIT_L
#undef PG8_BAR
#undef PG8_SCHED
#undef PG8_GIDX
#undef PG8_OC
#undef PG8_ON
}
}
#include <hip/hip_bf16.h>
#include <cmath>
namespace attn_body {
using bf16=__hip_bfloat16;
using bf16x8=__attribute__((ext_vector_type(8)))short;
using s16x4=__attribute__((ext_vector_type(4)))short;
using f32x16=__attribute__((ext_vector_type(16)))float;
using u32x4=__attribute__((ext_vector_type(4)))unsigned;
constexpr int SEQ=2048,D=64;
constexpr int NW=8,QBLK=32,QB=QBLK*NW,KVBLK=64,NQB=SEQ/QB;
constexpr int ATTN_UNIT_ROWS=QB;
struct AttnPtrs { const __hip_bfloat16* Q; const __hip_bfloat16* K; const __hip_bfloat16* V; __hip_bfloat16* O; int ldq, ldk, ldv, ldo; };
__device__ __forceinline__ int crow(int r,int hi){return (r&3)+8*(r>>2)+4*hi;}
#define SBAR() __builtin_amdgcn_sched_barrier(0)
__device__ __forceinline__ void cmask(f32x16&p0,f32x16&p1,int jb,int qrel,int hi){
  const float NEG=-INFINITY; int kb=64*jb+4*hi;
  #pragma unroll
  for(int r=0;r<16;++r){int kv=kb+(r&3)+8*(r>>2); if(kv>qrel)p0[r]=NEG; if(kv+32>qrel)p1[r]=NEG;}
}

constexpr int NSLOT=3, SLOTB=8192;
constexpr int LDS_K=0, LDS_V=NSLOT*SLOTB, LDS_WS=2*NSLOT*SLOTB, LDS_OST=LDS_WS+NW*64*4, LDS_BYTES=LDS_OST+NW*4096;
constexpr float C2=0.125f*1.4426950408889634f;
__device__ __forceinline__ void glds16(const void*gsrc,unsigned lds_dst){unsigned keep;
  asm volatile("s_mov_b32 %0, m0\n\ts_mov_b32 m0, %2\n\ts_nop 0\n\tglobal_load_lds_dwordx4 %1, off\n\ts_mov_b32 m0, %0":"=&s"(keep):"v"(gsrc),"s"(lds_dst):"memory");}
__device__ __forceinline__ float max3f(float a,float b,float c){float r;asm("v_max3_f32 %0, %1, %2, %3":"=v"(r):"v"(a),"v"(b),"v"(c));return r;}
__device__ __forceinline__ float max2f(float a,float b){float r;asm("v_max_f32_e32 %0, %1, %2":"=v"(r):"v"(a),"v"(b));return r;}
__device__ __forceinline__ float fadd_s(float a,float b){float r;asm("v_add_f32_e32 %0, %1, %2":"=v"(r):"v"(a),"v"(b));return r;}
__device__ __forceinline__ float fsub_s(float a,float b){float r;asm("v_sub_f32_e32 %0, %1, %2":"=v"(r):"v"(a),"v"(b));return r;}
typedef float f32x2_t __attribute__((ext_vector_type(2))); typedef __bf16 bf16x2_t __attribute__((ext_vector_type(2)));
__device__ __forceinline__ unsigned cvtpk_s(float lo,float hi){f32x2_t v={lo,hi};bf16x2_t b=__builtin_convertvector(v,bf16x2_t);return __builtin_bit_cast(unsigned,b);}
#define WAIT_BAR(N) asm volatile("s_waitcnt vmcnt(" #N ") lgkmcnt(0)\n\ts_barrier":::"memory")

__device__ __forceinline__ void qkt(f32x16&p0,f32x16&p1,const char*Kslot,const bf16x8*qr,const f32x16&negm,int r32,int hi){
  const char*kb=Kslot+hi*1024+r32*16;
  #pragma unroll
  for(int d0=0;d0<4;++d0){
    const bf16x8 b0=*reinterpret_cast<const bf16x8*>(kb+d0*2048);
    const bf16x8 b1=*reinterpret_cast<const bf16x8*>(kb+d0*2048+512);
    if(d0==0){p0=__builtin_amdgcn_mfma_f32_32x32x16_bf16(b0,qr[0],negm,0,0,0);p1=__builtin_amdgcn_mfma_f32_32x32x16_bf16(b1,qr[0],negm,0,0,0);}
    else{p0=__builtin_amdgcn_mfma_f32_32x32x16_bf16(b0,qr[d0],p0,0,0,0);p1=__builtin_amdgcn_mfma_f32_32x32x16_bf16(b1,qr[d0],p1,0,0,0);}}
}
typedef __attribute__((address_space(3))) const char* lds_cptr;
typedef short v4i16_t __attribute__((ext_vector_type(4)));
__device__ __forceinline__ void kload8(bf16x8*kf,lds_cptr kp){
  kf[0]=*(const __attribute__((address_space(3))) bf16x8*)(kp);      kf[1]=*(const __attribute__((address_space(3))) bf16x8*)(kp+512);
  kf[2]=*(const __attribute__((address_space(3))) bf16x8*)(kp+2048); kf[3]=*(const __attribute__((address_space(3))) bf16x8*)(kp+2560);
  kf[4]=*(const __attribute__((address_space(3))) bf16x8*)(kp+4096); kf[5]=*(const __attribute__((address_space(3))) bf16x8*)(kp+4608);
  kf[6]=*(const __attribute__((address_space(3))) bf16x8*)(kp+6144); kf[7]=*(const __attribute__((address_space(3))) bf16x8*)(kp+6656);
}
__device__ __forceinline__ void kload2(bf16x8*kf,lds_cptr kp,int j){ kf[2*j]=*(const __attribute__((address_space(3))) bf16x8*)(kp+j*2048); kf[2*j+1]=*(const __attribute__((address_space(3))) bf16x8*)(kp+j*2048+512); }
__device__ __forceinline__ s16x4 vtr(lds_cptr p){ return __builtin_bit_cast(s16x4,__builtin_amdgcn_ds_read_tr16_b64_v4i16((__attribute__((address_space(3))) v4i16_t*)p)); }
__device__ __forceinline__ float rowmax(const f32x16&p0,const f32x16&p1){
  float a=max3f(p0[0],p0[1],p1[0]),b=max3f(p0[2],p0[3],p1[1]);a=max3f(a,p1[2],p1[3]);
  #pragma unroll
  for(int r=4;r<16;r+=4){a=max3f(a,p0[r],p0[r+1]);b=max3f(b,p0[r+2],p0[r+3]);a=max3f(a,p1[r],p1[r+1]);b=max3f(b,p1[r+2],p1[r+3]);}
  const float m=max2f(a,b);
  auto rr=__builtin_amdgcn_permlane32_swap(__float_as_uint(m),__float_as_uint(m),false,false);
  return max2f(__uint_as_float(rr[0]),__uint_as_float(rr[1]));
}
__device__ __forceinline__ void pv(f32x16*o,int vb,bf16x8 pa0,bf16x8 pa1,bf16x8 pa2,bf16x8 pa3){
  #pragma unroll
  for(int d0=0;d0<2;++d0){s16x4 lo[4],hi[4];
    #pragma unroll
    for(int ks=0;ks<4;++ks){
      asm volatile("ds_read_b64_tr_b16 %0,%1 offset:%c2":"=&v"(lo[ks]):"v"(vb),"i"(d0*4096+ks*1024):"memory");
      asm volatile("ds_read_b64_tr_b16 %0,%1 offset:%c2":"=&v"(hi[ks]):"v"(vb),"i"(d0*4096+ks*1024+512):"memory");}
    asm volatile("s_waitcnt lgkmcnt(0)":::"memory");SBAR();
    #define PK(k) (bf16x8){lo[k][0],lo[k][1],lo[k][2],lo[k][3],hi[k][0],hi[k][1],hi[k][2],hi[k][3]}
    o[d0]=__builtin_amdgcn_mfma_f32_32x32x16_bf16(pa0,PK(0),o[d0],0,0,0);
    o[d0]=__builtin_amdgcn_mfma_f32_32x32x16_bf16(pa1,PK(1),o[d0],0,0,0);
    o[d0]=__builtin_amdgcn_mfma_f32_32x32x16_bf16(pa2,PK(2),o[d0],0,0,0);
    o[d0]=__builtin_amdgcn_mfma_f32_32x32x16_bf16(pa3,PK(3),o[d0],0,0,0);
    #undef PK
  }
}

#ifndef ATTN_STORE16
#define ATTN_STORE16(p,v) (*(u32x4*)(p)=(v))
#endif
template<int THRL> __device__ __forceinline__ void attn_unit(int qb,const AttnPtrs&P,char*shm){
  const int tid=threadIdx.x,lane=tid&63,r32=lane&31,hi=lane>>5; const int wid=__builtin_amdgcn_readfirstlane(tid>>6);
  const int q0=qb*QB; const long ldq=P.ldq,ldk=P.ldk,ldv=P.ldv,ldo=P.ldo;
  const bf16*Qw=P.Q+(long)(q0+wid*QBLK)*ldq;
  const bf16*Kh=P.K,*Vh=P.V;
  const unsigned lds0=(unsigned)(uintptr_t)shm;
  float*wsf=(float*)(shm+LDS_WS)+wid*64;
  const bf16*ksrc=Kh+(long)lane*ldk+wid*8;
  const bf16*vsrc=Vh+(long)(16*(wid&3)+(lane>>2))*ldv+(wid>>2)*32+(lane&3)*8;
  const unsigned kdst=lds0+LDS_K+wid*1024, vdst=lds0+LDS_V+wid*1024;
  #define DMA_K(t,slot) glds16(ksrc+(long)(t)*KVBLK*ldk,(unsigned)__builtin_amdgcn_readfirstlane(kdst+(slot)))
  #define DMA_V(t,slot) glds16(vsrc+(long)(t)*KVBLK*ldv,(unsigned)__builtin_amdgcn_readfirstlane(vdst+(slot)))
  const int vb0=(int)(lds0+LDS_V)+((lane>>4)&1)*32+(lane&3)*8+(4*hi+((lane&15)>>2))*64;
  const char*Kbase=shm+LDS_K; bf16x8 kf[8];
  const lds_cptr shm3=(lds_cptr)shm; const lds_cptr kp0=shm3+LDS_K+hi*1024+r32*16; const lds_cptr vp0=shm3+LDS_V+((lane>>4)&1)*32+(lane&3)*8+(4*hi+((lane&15)>>2))*64;
  constexpr int NT=SEQ/KVBLK;
  DMA_K(0,0);DMA_V(0,0);DMA_K(1,SLOTB);
  bf16x8 qr[4];
  #pragma unroll
  for(int d0=0;d0<4;++d0)qr[d0]=*reinterpret_cast<const bf16x8*>(&Qw[(long)r32*ldq+d0*16+hi*8]);
  float mhat=0.f,l_reg=0.f;f32x16 o[2];o[0]=f32x16{};o[1]=f32x16{};f32x16 negm=f32x16{};asm volatile("":"+v"(negm));
  #define CMASK(P0,P1,t) do{}while(0)
  bool resc=false;
  #define START(P0,P1) do{ const float rm=rowmax(P0,P1); resc=false; \
    { const float dl=rm; mhat=fadd_s(mhat,dl); \
      _Pragma("unroll") for(int r=0;r<16;++r){P0[r]=fsub_s(P0[r],dl);P1[r]=fsub_s(P1[r],dl);} \
      _Pragma("unroll") for(int r=0;r<16;++r)negm[r]=-mhat; asm volatile("":"+v"(negm)); } \
    _Pragma("unroll") for(int r=0;r<16;++r)P0[r]=__builtin_amdgcn_exp2f(P0[r]); }while(0)
  #define RESC() do{ if(resc){ asm volatile("s_waitcnt lgkmcnt(0)":::"memory"); \
      _Pragma("unroll") for(int d_=0;d_<2;++d_) _Pragma("unroll") for(int r=0;r<16;++r)o[d_][r]*=wsf[crow(r,hi)]; } }while(0)
  f32x16 pA0,pA1,pB0,pB1;
  int sl_prev=0,sl_cur=0,sl_next=SLOTB;
  #define ROT() do{sl_prev=sl_cur;sl_cur=sl_next;sl_next=(sl_next==(NSLOT-1)*SLOTB)?0:sl_next+SLOTB;}while(0)
  DMA_K(2,2*SLOTB);
  WAIT_BAR(3);
  qkt(pA0,pA1,Kbase,qr,negm,r32,hi);asm volatile("s_nop 15\n\ts_nop 7":"+v"(pA0),"+v"(pA1));CMASK(pA0,pA1,0);
  START(pA0,pA1);
  _Pragma("unroll") for(int r=0;r<16;++r)pA1[r]=__builtin_amdgcn_exp2f(pA1[r]);
  WAIT_BAR(0);
  DMA_K(3,0);DMA_V(1,SLOTB);
  ROT();
  kload8(kf,kp0+sl_cur);
  WAIT_BAR(2);
  s16x4 vlo[8],vhi[8]; u32x4 pw0,pw1,pw2,pw3;
  #define PKW(P,B) cvtpk_s(P[B],P[B+1])
  #define PAF(k) __builtin_bit_cast(bf16x8,pw##k)
  #define VFR(i) (bf16x8){vlo[i][0],vlo[i][1],vlo[i][2],vlo[i][3],vhi[i][0],vhi[i][1],vhi[i][2],vhi[i][3]}
  #define PIN(x) asm volatile("":"+v"(x))
  #define MX3(a,b,c) __builtin_fmaxf(__builtin_fmaxf((a),(b)),(c))
  #define GAPA(MF,A0,A1,A2,A3,W0,W1,PW) do{ MF; sacc+=A0; sacc+=A1; sacc+=A2; sacc+=A3; PIN(sacc); W0; W1; PIN(PW); SBAR(); }while(0)
  #define EX(v) __builtin_amdgcn_exp2f(v)
  #define GAPB(MF,X,B) do{ MF; X[B]=EX(X[B]); X[B+1]=EX(X[B+1]); X[B+2]=EX(X[B+2]); X[B+3]=EX(X[B+3]); PIN(X); SBAR(); }while(0)
  #define VRD(i) do{ vlo[i]=vtr(vp_+(((i)>>2)*4096+((i)&3)*1024)); vhi[i]=vtr(vp_+(((i)>>2)*4096+((i)&3)*1024+512)); }while(0)
  #define KRD(G,j) do{ if(G){ kload2(kf,kp0+sl_next,j); SBAR(); } }while(0)
  #define STEP(C0,C1,P0,P1,t,GK,GV,GL) do{ SBAR(); \
    const lds_cptr vp_=vp0+sl_prev; \
    VRD(0); SBAR(); float sacc=(P0[0]+P0[1]); \
    GAPA(C0=__builtin_amdgcn_mfma_f32_32x32x16_bf16(kf[0],qr[0],negm,0,0,0), P0[2],P0[3],P0[4],P0[5],     pw0[0]=PKW(P0,0), pw0[1]=PKW(P0,2), pw0); \
    VRD(4); SBAR(); GAPA(C1=__builtin_amdgcn_mfma_f32_32x32x16_bf16(kf[1],qr[0],negm,0,0,0), P0[6],P0[7],P0[8],P0[9],     pw0[2]=PKW(P0,4), pw0[3]=PKW(P0,6), pw0); \
    VRD(1); SBAR(); GAPA(C0=__builtin_amdgcn_mfma_f32_32x32x16_bf16(kf[2],qr[1],C0,0,0,0),   P0[10],P0[11],P0[12],P0[13], pw1[0]=PKW(P0,8), pw1[1]=PKW(P0,10), pw1); \
    VRD(5); SBAR(); GAPA(C1=__builtin_amdgcn_mfma_f32_32x32x16_bf16(kf[3],qr[1],C1,0,0,0),   P0[14],P0[15],P1[0],P1[1],   pw1[2]=PKW(P0,12),pw1[3]=PKW(P0,14), pw1); \
    VRD(2); SBAR(); GAPA(C0=__builtin_amdgcn_mfma_f32_32x32x16_bf16(kf[4],qr[2],C0,0,0,0),   P1[2],P1[3],P1[4],P1[5],     pw2[0]=PKW(P1,0), pw2[1]=PKW(P1,2), pw2); \
    VRD(6); SBAR(); GAPA(C1=__builtin_amdgcn_mfma_f32_32x32x16_bf16(kf[5],qr[2],C1,0,0,0),   P1[6],P1[7],P1[8],P1[9],     pw2[2]=PKW(P1,4), pw2[3]=PKW(P1,6), pw2); \
    VRD(3); SBAR(); GAPA(C0=__builtin_amdgcn_mfma_f32_32x32x16_bf16(kf[6],qr[3],C0,0,0,0),   P1[10],P1[11],P1[12],P1[13], pw3[0]=PKW(P1,8), pw3[1]=PKW(P1,10), pw3); \
    VRD(7); SBAR(); GAPA(C1=__builtin_amdgcn_mfma_f32_32x32x16_bf16(kf[7],qr[3],C1,0,0,0),   P1[14],P1[15],0.f,0.f,       pw3[2]=PKW(P1,12),pw3[3]=PKW(P1,14), pw3); \
    l_reg+=sacc; \
    if(GK){DMA_K((t)+3,sl_cur);} if(GV){DMA_V((t)+1,sl_next);} \
    CMASK(C0,C1,t); \
    { float a=MX3(C0[0],C0[1],C1[0]),b=MX3(C0[2],C0[3],C1[1]); a=MX3(a,C1[2],C1[3]); \
      _Pragma("unroll") for(int r=4;r<16;r+=4){a=MX3(a,C0[r],C0[r+1]);b=MX3(b,C0[r+2],C0[r+3]);a=MX3(a,C1[r],C1[r+1]);b=MX3(b,C1[r+2],C1[r+3]);} \
      float rm=__builtin_fmaxf(a,b); { auto rr=__builtin_amdgcn_permlane32_swap(__float_as_uint(rm),__float_as_uint(rm),false,false); rm=__builtin_fmaxf(__uint_as_float(rr[0]),__uint_as_float(rr[1])); } \
      resc=false; \
      if(__builtin_expect(__any(rm>(float)THRL),0)){ const float dl=__builtin_fmaxf(rm,0.f); mhat+=dl; \
        _Pragma("unroll") for(int r=0;r<16;++r){C0[r]-=dl;C1[r]-=dl;} \
        _Pragma("unroll") for(int r=0;r<16;++r)negm[r]=-mhat; asm volatile("":"+v"(negm)); \
        const float f=__builtin_amdgcn_exp2f(-dl); l_reg*=f; if(hi==0)wsf[r32]=f; resc=true; } } \
    SBAR(); \
    GAPB(o[0]=__builtin_amdgcn_mfma_f32_32x32x16_bf16(PAF(0),VFR(0),o[0],0,0,0), C0,0); \
    GAPB(o[1]=__builtin_amdgcn_mfma_f32_32x32x16_bf16(PAF(0),VFR(4),o[1],0,0,0), C0,4); \
    KRD(GL,0); GAPB(o[0]=__builtin_amdgcn_mfma_f32_32x32x16_bf16(PAF(1),VFR(1),o[0],0,0,0), C0,8); \
    KRD(GL,1); GAPB(o[1]=__builtin_amdgcn_mfma_f32_32x32x16_bf16(PAF(1),VFR(5),o[1],0,0,0), C0,12); \
    KRD(GL,2); GAPB(o[0]=__builtin_amdgcn_mfma_f32_32x32x16_bf16(PAF(2),VFR(2),o[0],0,0,0), C1,0); \
    KRD(GL,3); GAPB(o[1]=__builtin_amdgcn_mfma_f32_32x32x16_bf16(PAF(2),VFR(6),o[1],0,0,0), C1,4); \
    GAPB(o[0]=__builtin_amdgcn_mfma_f32_32x32x16_bf16(PAF(3),VFR(3),o[0],0,0,0), C1,8); \
    GAPB(o[1]=__builtin_amdgcn_mfma_f32_32x32x16_bf16(PAF(3),VFR(7),o[1],0,0,0), C1,12); \
    }while(0)
  int t=1;
  for(;t+5<NT;t+=2){
    STEP(pB0,pB1,pA0,pA1,t,true,true,true);     WAIT_BAR(2); RESC(); ROT();
    STEP(pA0,pA1,pB0,pB1,t+1,true,true,true);   WAIT_BAR(2); RESC(); ROT();
  }
  #define ENDW(tt) do{ if((tt)+3<NT){WAIT_BAR(2);} else if((tt)+2<NT){WAIT_BAR(1);} else {WAIT_BAR(0);} }while(0)
  for(;t+1<NT;t+=2){
    STEP(pB0,pB1,pA0,pA1,t,(t+3<NT),(t+1<NT),(t+1<NT));       ENDW(t);   RESC(); ROT();
    STEP(pA0,pA1,pB0,pB1,t+1,(t+4<NT),(t+2<NT),(t+2<NT));     ENDW(t+1); RESC(); ROT();
  }
  STEP(pB0,pB1,pA0,pA1,NT-1,false,false,false); RESC();
  { float sacc=pB0[0]+pB0[1]; _Pragma("unroll") for(int r=2;r<16;++r)sacc+=pB0[r]; _Pragma("unroll") for(int r=0;r<16;++r)sacc+=pB1[r]; l_reg+=sacc;
    pw0=(u32x4){PKW(pB0,0),PKW(pB0,2),PKW(pB0,4),PKW(pB0,6)};pw1=(u32x4){PKW(pB0,8),PKW(pB0,10),PKW(pB0,12),PKW(pB0,14)};pw2=(u32x4){PKW(pB1,0),PKW(pB1,2),PKW(pB1,4),PKW(pB1,6)};pw3=(u32x4){PKW(pB1,8),PKW(pB1,10),PKW(pB1,12),PKW(pB1,14)};
    SBAR(); pv(o,vb0+sl_cur,PAF(0),PAF(1),PAF(2),PAF(3)); }
  #undef PKW
  #undef PAF
  #undef VFR
  #undef PIN
  #undef MX3
  #undef GAPA
  #undef GAPB
  #undef EX
  #undef VRD
  #undef KRD
  #undef STEP
  #undef ENDW
  {auto rr=__builtin_amdgcn_permlane32_swap(__float_as_uint(l_reg),__float_as_uint(l_reg),false,false);l_reg=__uint_as_float(rr[0])+__uint_as_float(rr[1]);}
  if(hi==0)wsf[32+r32]=l_reg;asm volatile("s_waitcnt lgkmcnt(0)":::"memory");
  float rli[16];
  #pragma unroll
  for(int r=0;r<16;++r)rli[r]=__builtin_amdgcn_rcpf(wsf[32+crow(r,hi)]);
  bf16*Ow=P.O+(long)(q0+wid*QBLK)*ldo;
  { bf16*stg=(bf16*)(shm+LDS_OST)+wid*2048;
    #pragma unroll
    for(int r=0;r<16;++r){const int orow=crow(r,hi);
      #pragma unroll
      for(int d0=0;d0<2;++d0)stg[orow*64+d0*32+r32]=__float2bfloat16(o[d0][r]*rli[r]);}
    asm volatile("s_waitcnt lgkmcnt(0)":::"memory");
    #pragma unroll
    for(int i=0;i<4;++i){const int row=i*8+(lane>>3),ch=lane&7; const u32x4 v=*(const u32x4*)(stg+row*64+ch*8); ATTN_STORE16(Ow+(long)row*ldo+ch*8,v);} }
  asm volatile("s_waitcnt lgkmcnt(0)\n\ts_barrier":::"memory");
  #undef DMA_K
  #undef DMA_V
  #undef CMASK
  #undef START
  #undef RESC
  #undef ROT
}
constexpr int ATTN_LDS_BYTES=LDS_BYTES;
#undef SBAR
#undef WAIT_BAR
}

constexpr int NWAVES = 8;
constexpr int NB = 8, SEQ = 2048, D = 1024, M = NB * SEQ, MEMT = 256, DIN = 2304, NE = 32, TOPK = 4, CAP = M;
constexpr float ALPHA = 1.189207115002721f;
constexpr float LN_EPS = 1e-5f, RMS_EPS = 1e-6f, LAMBDA_INIT = 0.2f;
constexpr float LOG2E = 1.4426950408889634f;
constexpr float C2M = 0.0625f * LOG2E;
constexpr int HROWS = 73728;
constexpr int NPHASE = 17;
constexpr float WSCALE = 64.0f;

constexpr size_t MiB = 1u << 20;
constexpr size_t WS_CTL = 0, CTL_ZERO_BYTES = 1 * MiB;
constexpr size_t WS_WIN = 1 * MiB;
constexpr size_t WS_WMIX = 6 * MiB;
constexpr size_t WS_WQ = 8 * MiB;
constexpr size_t WS_WKV = 10 * MiB;
constexpr size_t WS_WO = 14 * MiB;
constexpr size_t WS_TAB = 16 * MiB;
constexpr size_t WS_WD = 17 * MiB;
constexpr size_t WS_WGU = 81 * MiB;
constexpr size_t WS_XB = 209 * MiB;
constexpr size_t WS_HRAW = 241 * MiB;
constexpr size_t WS_S = 241 * MiB, WS_X2 = 241 * MiB;
constexpr size_t WS_QA = 313 * MiB, WS_KA = 329 * MiB, WS_QB = 333 * MiB, WS_KB = 349 * MiB;
constexpr size_t WS_X1 = 313 * MiB;
constexpr size_t WS_OT = 377 * MiB;
constexpr size_t WS_QM = 377 * MiB, WS_P = 409 * MiB, WS_XO = 377 * MiB;
constexpr size_t WS_AO = 441 * MiB;
constexpr size_t WS_MEMK = 473 * MiB, WS_MEMVT = 477 * MiB, WS_MEMB = 481 * MiB;
constexpr size_t WS_LIST = 485 * MiB;
constexpr size_t WS_SEL = 487 * MiB;
constexpr size_t WS_H = 305 * MiB;
constexpr size_t WS_Y = 81 * MiB;
constexpr size_t WS_END = 512 * MiB;
constexpr int TB_COSS = 0, TB_SINS = 65536, TB_COSR = 131072, TB_SINR = 131584, TB_COSC = 132096, TB_SINC = 133120, TB_WRT = 134144;
constexpr int CW_TMO = 0, CW_CODE = 1, CW_CNT = 2048  , CW_BAR = 4096  ;

constexpr int RING_OFF = 0, RING_BYTES = 131072;
constexpr int IDX_OFF = RING_BYTES, IDX_BYTES = 12 * 1024;
constexpr int TILE_OFF = IDX_OFF + IDX_BYTES;
constexpr int TILE_BYTES = 320 * 4 + 32 * 4 + 32 * 4 + 16;
constexpr int LDSCTL_OFF = TILE_OFF + TILE_BYTES, MISC_OFF = LDSCTL_OFF + 64;
constexpr int LDS_BYTES = 147456;
static_assert(MISC_OFF + 128 <= LDS_BYTES, "LDS map");
#define GAS __attribute__((address_space(1)))
#define LAS __attribute__((address_space(3)))
typedef unsigned short bf16;
typedef unsigned v4u __attribute__((ext_vector_type(4)));
typedef float f32x4 __attribute__((ext_vector_type(4)));
typedef short bf16x8 __attribute__((ext_vector_type(8)));
typedef GAS unsigned gu32;
typedef GAS unsigned long long gu64;
#define RLX_AGENT __ATOMIC_RELAXED, __HIP_MEMORY_SCOPE_AGENT
#define LDS_WAIT() asm volatile("s_waitcnt lgkmcnt(0)" ::: "memory")
#define VM_WAIT() asm volatile("s_waitcnt vmcnt(0)" ::: "memory")
__device__ __forceinline__ unsigned long long rt() { return __builtin_amdgcn_s_memrealtime(); }
__device__ __forceinline__ unsigned f2bf(float f) { unsigned u = __builtin_bit_cast(unsigned, f); return (u + 0x7fffu + ((u >> 16) & 1u)) >> 16; }
__device__ __forceinline__ unsigned pk2(float lo, float hi) { return f2bf(lo) | (f2bf(hi) << 16); }

#define XB_TMO      128
#define XB_XCNT(j)  (256  + 64 * (j))
#define XB_XSUB(j)  (1280 + 64 * (j))
#define XB_XGEN(j)  (2304 + 64 * (j))
#define XB_TOP      3328
#define XB_TOPGEN   3392
#define XCD_BAR_WORDS 3456
#define XB_SPIN_CAP (1u << 18)

__device__ __forceinline__ unsigned xb_ld(unsigned* p)              { return __hip_atomic_load(p, __ATOMIC_RELAXED, __HIP_MEMORY_SCOPE_AGENT); }
__device__ __forceinline__ unsigned xb_add(unsigned* p, unsigned v) { return __hip_atomic_fetch_add(p, v, __ATOMIC_RELAXED, __HIP_MEMORY_SCOPE_AGENT); }
__device__ __forceinline__ unsigned xb_xcc_id() { return (unsigned)__builtin_amdgcn_s_getreg((3 << 11) | 20) & 0xFu; }
#define XB_SPIN(cond, bar) do { unsigned _sp = 0; while (cond) { __builtin_amdgcn_s_sleep(1); \
    if ((++_sp & 255u) == 0u) { if (xb_ld(&(bar)[XB_TMO])) break; if (_sp > XB_SPIN_CAP) { atomicAdd(&(bar)[XB_TMO], 1u); break; } } } } while (0)

struct XcdBarrier {
    unsigned* bar; unsigned x;
    volatile LAS unsigned* st;
};

__device__ __forceinline__ XcdBarrier xcd_barrier_post(unsigned* bar, volatile LAS unsigned* st) {
    XcdBarrier b; b.bar = bar; b.x = xb_xcc_id(); b.st = st;
    if (threadIdx.x == 0) (void)xb_add(&bar[XB_XCNT(b.x)], 1u);
    return b;
}
__device__ __forceinline__ void xcd_barrier_complete(unsigned* bar, unsigned x, unsigned& nloc, unsigned& nx) {
    const unsigned G = gridDim.x * gridDim.y * gridDim.z;
    unsigned sum, cnt, mine, sp = 0u;
    for (;;) {
        sum = 0u; cnt = 0u; mine = 0u;
#pragma unroll
        for (unsigned j = 0; j < 16; ++j) { const unsigned c = xb_ld(&bar[XB_XCNT(j)]); sum += c; cnt += (c > 0u) ? 1u : 0u; mine = (j == x) ? c : mine; }
        if (sum == G) break;
        __builtin_amdgcn_s_sleep(1);
        if ((++sp & 255u) == 0u) { if (xb_ld(&bar[XB_TMO])) break; if (sp > XB_SPIN_CAP) { atomicAdd(&bar[XB_TMO], 1u); break; } }
    }
    nloc = mine > 0u ? mine : 1u; nx = cnt > 0u ? cnt : 1u;
}

__device__ __forceinline__ void xcd_barrier(const XcdBarrier& b) {
    asm volatile("s_waitcnt vmcnt(0)" ::: "memory");
    __syncthreads();
    if (threadIdx.x == 0) {
        unsigned* bar = b.bar;
        __builtin_amdgcn_s_waitcnt(0);
        unsigned nloc = b.st[0], nx = b.st[1];
        if (nloc == 0u) { xcd_barrier_complete(bar, b.x, nloc, nx); b.st[0] = nloc; b.st[1] = nx; }
        const unsigned old = xb_add(&bar[XB_XSUB(b.x)], 1u);
        const unsigned gen = old / nloc;
        if (old + 1u == (gen + 1u) * nloc) {
            __builtin_amdgcn_fence(__ATOMIC_RELEASE, "agent");
            asm volatile("s_waitcnt vmcnt(0)" ::: "memory");
            const unsigned og = xb_add(&bar[XB_TOP], 1u);
            const unsigned tg = og / nx;
            if (og + 1u == (tg + 1u) * nx) xb_add(&bar[XB_TOPGEN], 1u);
            else XB_SPIN(xb_ld(&bar[XB_TOPGEN]) == tg, bar);
            __builtin_amdgcn_fence(__ATOMIC_ACQUIRE, "agent");
            xb_add(&bar[XB_XGEN(b.x)], 1u);
            asm volatile("s_waitcnt vmcnt(0)" ::: "memory");
        } else {
            XB_SPIN(xb_ld(&bar[XB_XGEN(b.x)]) == gen, bar);
            __builtin_amdgcn_fence(__ATOMIC_ACQUIRE, "agent");
            asm volatile("s_waitcnt vmcnt(0)" ::: "memory");
        }
    }
    __syncthreads();
}

struct Frame {
    LAS unsigned char* lds;
    volatile LAS unsigned* MISC;
    gu32* ctl;
    int tid, lane, wave, vcu, G;
    unsigned char* ws;
};
__device__ __forceinline__ float wave_sum(float v) {
#pragma unroll
    for (int o = 1; o < 64; o <<= 1) v += __shfl_xor(v, o);
    return v;
}
__device__ __forceinline__ float wave_max(float v) {
#pragma unroll
    for (int o = 1; o < 64; o <<= 1) v = fmaxf(v, __shfl_xor(v, o));
    return v;
}
__device__ __forceinline__ float bf2f(unsigned short b) { return __uint_as_float((unsigned)b << 16); }

__device__ __forceinline__ void p0_transpose_item(const float* W, int K, int N, bf16* WT, int kb, int n0, int drow0, LAS float* scr, int lane) {
    const int k0 = 64 * kb;
#pragma unroll 8
    for (int i = 0; i < 32; ++i) { const int kk = 2 * i + (lane >> 5); scr[kk * 33 + (lane & 31)] = W[(size_t)(k0 + kk) * N + n0 + (lane & 31)]; }
    LDS_WAIT(); asm volatile("" ::: "memory");
    const int c = lane & 7;
#pragma unroll
    for (int j = 0; j < 4; ++j) { const int n = (lane >> 3) + 8 * j; const LAS float* s = scr + (8 * c) * 33 + n;
        v4u o; o.x = pk2(s[0 * 33], s[1 * 33]); o.y = pk2(s[2 * 33], s[3 * 33]); o.z = pk2(s[4 * 33], s[5 * 33]); o.w = pk2(s[6 * 33], s[7 * 33]);
        *(GAS v4u*)(WT + (size_t)(drow0 + n) * K + k0 + 8 * c) = o; }
    LDS_WAIT(); asm volatile("" ::: "memory");
}
__device__ __forceinline__ void p0_transpose_item_fp8(const float* W, int K, int N, unsigned char* WT, int kb, int n0, int drow0, float sc, LAS float* scr, int lane) {
    const int k0 = 64 * kb;
#pragma unroll 8
    for (int i = 0; i < 32; ++i) { const int kk = 2 * i + (lane >> 5); scr[kk * 33 + (lane & 31)] = W[(size_t)(k0 + kk) * N + n0 + (lane & 31)]; }
    LDS_WAIT(); asm volatile("" ::: "memory");
    const int c = lane & 3;
#pragma unroll
    for (int j = 0; j < 2; ++j) { const int n = (lane >> 2) + 16 * j; const LAS float* s = scr + (16 * c) * 33 + n;
        unsigned w[4];
#pragma unroll
        for (int q = 0; q < 4; ++q) { float a0 = s[(4 * q) * 33] * sc, a1 = s[(4 * q + 1) * 33] * sc, a2 = s[(4 * q + 2) * 33] * sc, a3 = s[(4 * q + 3) * 33] * sc;
            a0 = fminf(fmaxf(a0, -448.f), 448.f); a1 = fminf(fmaxf(a1, -448.f), 448.f); a2 = fminf(fmaxf(a2, -448.f), 448.f); a3 = fminf(fmaxf(a3, -448.f), 448.f);
            unsigned x = 0u; x = __builtin_amdgcn_cvt_pk_fp8_f32(a0, a1, x, false); x = __builtin_amdgcn_cvt_pk_fp8_f32(a2, a3, x, true); w[q] = x; }
        v4u o; o.x = w[0]; o.y = w[1]; o.z = w[2]; o.w = w[3];
        *(GAS v4u*)(WT + (size_t)(drow0 + n) * K + k0 + 16 * c) = o; }
    LDS_WAIT(); asm volatile("" ::: "memory");
}
__device__ __forceinline__ void row_f32_to_bf16(const float* xrow, bf16* orow, int lane) {
    const GAS f32x4* xr = (const GAS f32x4*)xrow + lane;
    GAS unsigned long long* o8 = (GAS unsigned long long*)orow + lane;
#pragma unroll
    for (int j = 0; j < 4; ++j) { const f32x4 v = xr[64 * j]; o8[64 * j] = (unsigned long long)pk2(v.x, v.y) | ((unsigned long long)pk2(v.z, v.w) << 32); }
}
struct Ins { const float* p[28]; };
__device__ __forceinline__ void p0_prologue(Frame& F, const Ins& I) {
    LAS float* scr = (LAS float*)(F.lds + RING_OFF + F.wave * 16384);
    const int gw = F.vcu * NWAVES + F.wave, NGW = F.G * NWAVES;
    unsigned char* ws = F.ws;
    constexpr int I_IN = 16 * 72, I_SQ = 16 * 32, I_KV = 16 * 64, I_SMALL = I_IN + 3 * I_SQ + I_KV, NITEMS = I_SMALL + NE * 3 * I_SQ;
    for (int it = gw; it < NITEMS; it += NGW) {
        int r = it;
        if (r < I_IN) { p0_transpose_item(I.p[2], D, DIN, (bf16*)(ws + WS_WIN), r / 72, 32 * (r % 72), 32 * (r % 72), scr, F.lane); continue; } r -= I_IN;
        if (r < I_SQ) { p0_transpose_item(I.p[10], D, D, (bf16*)(ws + WS_WMIX), r / 32, 32 * (r % 32), 32 * (r % 32), scr, F.lane); continue; } r -= I_SQ;
        if (r < I_SQ) { p0_transpose_item(I.p[13], D, D, (bf16*)(ws + WS_WQ), r / 32, 32 * (r % 32), 32 * (r % 32), scr, F.lane); continue; } r -= I_SQ;
        if (r < I_KV) { p0_transpose_item(I.p[14], D, 2 * D, (bf16*)(ws + WS_WKV), r / 64, 32 * (r % 64), 32 * (r % 64), scr, F.lane); continue; } r -= I_KV;
        if (r < I_SQ) { p0_transpose_item(I.p[15], D, D, (bf16*)(ws + WS_WO), r / 32, 32 * (r % 32), 32 * (r % 32), scr, F.lane); continue; } r -= I_SQ;
        const int e = r / (3 * I_SQ), q = r % (3 * I_SQ), which = q / I_SQ, j = q % I_SQ, kb = j / 32, n0 = 32 * (j % 32);
        if (which == 0)      p0_transpose_item_fp8(I.p[20] + (size_t)e * D * D, D, D, ws + WS_WGU + (size_t)e * 2048 * D, kb, n0, (n0 >> 7) * 256 + (n0 & 127), WSCALE, scr, F.lane);
        else if (which == 1) p0_transpose_item_fp8(I.p[22] + (size_t)e * D * D, D, D, ws + WS_WGU + (size_t)e * 2048 * D, kb, n0, (n0 >> 7) * 256 + 128 + (n0 & 127), WSCALE, scr, F.lane);
        else                 p0_transpose_item_fp8(I.p[24] + (size_t)e * D * D, D, D, ws + WS_WD + (size_t)e * D * D, kb, n0, n0, WSCALE, scr, F.lane);
    }
    for (int m = gw; m < M; m += NGW) row_f32_to_bf16(I.p[0] + (size_t)m * D, (bf16*)(ws + WS_XB) + (size_t)m * D, F.lane);
    for (int m = gw; m < NB * MEMT; m += NGW) row_f32_to_bf16(I.p[1] + (size_t)m * D, (bf16*)(ws + WS_MEMB) + (size_t)m * D, F.lane);
    float* tab = (float*)(ws + WS_TAB);
    const int gt = F.vcu * (NWAVES * 64) + F.tid, NGT = F.G * NWAVES * 64;
    for (int i = gt; i < 65536; i += NGT) { const int s = i >> 5, f = i & 31; const float inv = powf(10000.0f, -(float)(2 * f) / 64.0f); const float ang = (float)s * inv; tab[TB_COSS + i] = cosf(ang); tab[TB_SINS + i] = sinf(ang); }
    for (int i = gt; i < 1536; i += NGT) {
        const bool isr = i < 512; const int j = isr ? i : i - 512, pos = j >> 4, f = j & 15; const float inv = powf(10000.0f, -(float)(2 * f) / 32.0f); const float ang = (float)pos * inv;
        if (isr) { tab[TB_COSR + j] = cosf(ang); tab[TB_SINR + j] = sinf(ang); } else { tab[TB_COSC + j] = cosf(ang); tab[TB_SINC + j] = sinf(ang); } }
    for (int i = gt; i < 32768; i += NGT) { const int e = i >> 10, k = i & 1023; tab[TB_WRT + i] = I.p[18][(size_t)k * NE + e]; }
}

struct SchedP1 {
    int G, c; const char* xb; const char* win; const char* memb; const char* wkv; bf16* hraw; bf16* memk; bf16* memvt;
    __device__ __forceinline__ bool next(int i, pg8::Unit& u) const {
        const long L = (long)i * G + c; u.gidx = 0; u.aux = 0;
        if (L < 576) { const int nM = 64, nN = 9, nwg = 576; int wgid = (int)L; { const int q = nwg / 8, xcd = wgid % 8, off = wgid / 8; wgid = xcd * q + off; }
            const int nig = 8 * nN, gid = wgid / nig, fm = gid * 8, gsz = (nM - fm) < 8 ? (nM - fm) : 8; const int pm = fm + ((wgid % nig) % gsz), pn = (wgid % nig) / gsz;
            u.A = xb + (size_t)pm * 256 * 2048; u.B = win + (size_t)pn * 256 * 2048; u.orow = pm * 256; u.ocol = pn * 256; u.O = hraw; u.ldo = DIN; return true; }
        if (L < 608) { const int j = (int)L - 576, pm = j >> 2, pn = j & 3; u.A = memb + (size_t)pm * 256 * 2048; u.B = wkv + (size_t)pn * 256 * 2048; u.orow = pm * 256; u.ocol = pn * 256; u.O = memk; u.ldo = D; return true; }
        if (L < 640) { const int j = (int)L - 608, b = j >> 2, pm = j & 3; u.A = wkv + (size_t)(1024 + pm * 256) * 2048; u.B = memb + (size_t)b * 256 * 2048; u.orow = b * 1024 + pm * 256; u.ocol = 0; u.O = memvt; u.ldo = 256; return true; }
        return false;
    }
};
struct SchedPlain {
    int nM, nN, nwg, G, c; const char* A; const char* B; size_t astep, bstep;
    __device__ __forceinline__ bool next(int i, pg8::Unit& u) const {
        const long L = (long)i * G + c; if (L >= nwg) return false;
        int wgid = (int)L; { const int q = nwg / 8, r = nwg % 8, xcd = wgid % 8, off = wgid / 8; wgid = (xcd < r ? xcd * (q + 1) : r * (q + 1) + (xcd - r) * q) + off; }
        const int nig = 8 * nN, gid = wgid / nig, fm = gid * 8, gsz = (nM - fm) < 8 ? (nM - fm) : 8; const int pm = fm + ((wgid % nig) % gsz), pn = (wgid % nig) / gsz;
        u.A = A + (size_t)pm * astep; u.B = B + (size_t)pn * bstep; u.orow = pm * 256; u.ocol = pn * 256; u.O = nullptr; u.ldo = 0; u.aux = 0; u.gidx = 0; return true;
    }
};

__device__ __forceinline__ void t1_norm_rope(Frame& F, const Ins& I) {
    unsigned char* ws = F.ws; const int lane = F.lane;
    const bf16* hraw = (const bf16*)(ws + WS_HRAW); const float* tab = (const float*)(ws + WS_TAB);
    bf16* QA = (bf16*)(ws + WS_QA); bf16* KA = (bf16*)(ws + WS_KA); bf16* QB = (bf16*)(ws + WS_QB); bf16* KB = (bf16*)(ws + WS_KB);
    const float gq = I.p[3][lane], gk = I.p[4][lane];
    const int gw = F.vcu * NWAVES + F.wave, NGW = F.G * NWAVES;
    const float C2A = 0.125f * LOG2E;
    for (int t = gw; t < M; t += NGW) {
        const int s = t & (SEQ - 1); const bf16* hr = hraw + (size_t)t * DIN;
        float va[10], vb[16];
#pragma unroll
        for (int j = 0; j < 10; ++j) va[j] = bf2f(hr[j * 64 + lane]);
#pragma unroll
        for (int j = 0; j < 16; ++j) vb[j] = bf2f(hr[768 + j * 64 + lane]);
        {
            const int sub = lane >> 5, jj = lane & 31, f = jj & 15, pos = sub == 0 ? (s >> 6) : (s & 63);
            const float c = sub == 0 ? tab[TB_COSR + pos * 16 + f] : tab[TB_COSC + pos * 16 + f], sn = sub == 0 ? tab[TB_SINR + pos * 16 + f] : tab[TB_SINC + pos * 16 + f];
#pragma unroll
            for (int j = 0; j < 10; ++j) {
                const float ss = wave_sum(va[j] * va[j]);
                const float y = va[j] * (1.0f / sqrtf(ss * (1.0f / 64.0f) + RMS_EPS)) * (j < 8 ? gq : gk);
                const float p = __shfl_xor(y, 16);
                float o = (jj < 16) ? (y * c - p * sn) : (y * c + p * sn);
                if (j < 8) QA[(size_t)t * 512 + j * 64 + lane] = (bf16)f2bf(o * C2A); else KA[(size_t)t * 128 + (j - 8) * 64 + lane] = (bf16)f2bf(o);
            }
        }
        {
            const int f = lane & 31; const float c = tab[TB_COSS + s * 32 + f], sn = tab[TB_SINS + s * 32 + f];
#pragma unroll
            for (int j = 0; j < 16; ++j) {
                const float p = __shfl_xor(vb[j], 32);
                const float o = (lane < 32) ? (vb[j] * c - p * sn) : (vb[j] * c + p * sn);
                if (j < 8) QB[(size_t)t * 512 + j * 64 + lane] = (bf16)f2bf(o * C2A); else KB[(size_t)t * 512 + (j - 8) * 64 + lane] = (bf16)f2bf(o);
            }
        }
    }
}

__device__ __forceinline__ bool attn_unit_ptrs(unsigned char* ws, long L, attn_body::AttnPtrs& P, int& qb) {
    using abf = __hip_bfloat16;
    if (L >= 1536) return false;
    const int r = (int)(L >> 8), v = (int)(L & 255), xcd = v >> 5, w = v & 31; qb = w & 7;
    if (r < 2) { const int idx = r * 8 + xcd, b = idx >> 1, g = idx & 1, h = g * 4 + (w >> 3);
        P.Q = (const abf*)(ws + WS_QA) + (size_t)b * SEQ * 512 + h * 64; P.ldq = 512;
        P.K = (const abf*)(ws + WS_KA) + (size_t)b * SEQ * 128 + g * 64; P.ldk = 128;
        P.V = (const abf*)(ws + WS_HRAW) + (size_t)b * SEQ * DIN + 640 + g * 64; P.ldv = DIN;
        P.O = (abf*)(ws + WS_AO) + (size_t)b * SEQ * 1024 + h * 64; P.ldo = 1024;
    } else { const int idx = (r - 2) * 8 + xcd, b = idx >> 2, h = idx & 3, c = w >> 4, vh = (w >> 3) & 1;
        P.Q = (const abf*)(ws + WS_QB) + (size_t)b * SEQ * 512 + (h * 2 + c) * 64; P.ldq = 512;
        P.K = (const abf*)(ws + WS_KB) + (size_t)b * SEQ * 512 + (h * 2 + c) * 64; P.ldk = 512;
        P.V = (const abf*)(ws + WS_HRAW) + (size_t)b * SEQ * DIN + 1792 + h * 128 + vh * 64; P.ldv = DIN;
        P.O = (abf*)(ws + WS_OT) + (size_t)c * M * 512 + (size_t)b * SEQ * 512 + h * 128 + vh * 64; P.ldo = 512;
    }
    return true;
}

__device__ __forceinline__ void t2_diff_combine(Frame& F, const Ins& I) {
    unsigned char* ws = F.ws; const int lane = F.lane;
    const bf16* OT = (const bf16*)(ws + WS_OT); bf16* AO = (bf16*)(ws + WS_AO);
    const float lam = expf(wave_sum(I.p[5][lane] * I.p[6][lane])) - expf(wave_sum(I.p[7][lane] * I.p[8][lane])) + LAMBDA_INIT;
    const float g0 = I.p[9][2 * lane] * (1.0f - LAMBDA_INIT), g1 = I.p[9][2 * lane + 1] * (1.0f - LAMBDA_INIT);
    const int gw = F.vcu * NWAVES + F.wave, NGW = F.G * NWAVES;
    for (int it = gw; it < M * 4; it += NGW) {
        const int t = it >> 2, hh = it & 3;
        const unsigned a = *(const GAS unsigned*)(OT + (size_t)t * 512 + hh * 128 + 2 * lane), b = *(const GAS unsigned*)(OT + (size_t)M * 512 + (size_t)t * 512 + hh * 128 + 2 * lane);
        const float v0 = bf2f((unsigned short)(a & 0xffffu)) - lam * bf2f((unsigned short)(b & 0xffffu)), v1 = bf2f((unsigned short)(a >> 16)) - lam * bf2f((unsigned short)(b >> 16));
        const float ss = wave_sum(v0 * v0 + v1 * v1);
        const float r = 1.0f / sqrtf(ss * (1.0f / 128.0f) + RMS_EPS);
        *(GAS unsigned*)(AO + (size_t)t * 1024 + 512 + hh * 128 + 2 * lane) = pk2(v0 * r * g0, v1 * r * g1);
    }
}

template <bool Q8> __device__ __forceinline__ void ln_rows(Frame& F, float* X, bf16* XB, const float* g, const float* bta) {
    const int lane = F.lane; const int gw = F.vcu * NWAVES + F.wave, NGW = F.G * NWAVES;
    f32x4 gg[4], bb[4];
#pragma unroll
    for (int j = 0; j < 4; ++j) { gg[j] = ((const GAS f32x4*)g)[lane + 64 * j]; bb[j] = ((const GAS f32x4*)bta)[lane + 64 * j]; }
    for (int m = gw; m < M; m += NGW) {
        GAS f32x4* xr = (GAS f32x4*)(X + (size_t)m * D) + lane;
        f32x4 v[4]; float s = 0.f;
#pragma unroll
        for (int j = 0; j < 4; ++j) { v[j] = xr[64 * j]; s += (v[j].x + v[j].y) + (v[j].z + v[j].w); }
        const float mean = wave_sum(s) * (1.f / D); float s2 = 0.f;
#pragma unroll
        for (int j = 0; j < 4; ++j) { v[j] = v[j] - mean; s2 += (v[j].x * v[j].x + v[j].y * v[j].y) + (v[j].z * v[j].z + v[j].w * v[j].w); }
        const float rstd = 1.f / sqrtf(wave_sum(s2) * (1.f / D) + LN_EPS);
        GAS unsigned long long* o8 = (GAS unsigned long long*)(XB + (size_t)m * D) + lane;
        GAS unsigned* o4 = (GAS unsigned*)((unsigned char*)XB + (size_t)m * D) + lane;
#pragma unroll
        for (int j = 0; j < 4; ++j) { const f32x4 o = v[j] * rstd * gg[j] + bb[j]; xr[64 * j] = o;
            if constexpr (Q8) { unsigned x = 0u; x = __builtin_amdgcn_cvt_pk_fp8_f32(fminf(fmaxf(o.x, -448.f), 448.f), fminf(fmaxf(o.y, -448.f), 448.f), x, false);
                x = __builtin_amdgcn_cvt_pk_fp8_f32(fminf(fmaxf(o.z, -448.f), 448.f), fminf(fmaxf(o.w, -448.f), 448.f), x, true); o4[64 * j] = x; }
            else o8[64 * j] = (unsigned long long)pk2(o.x, o.y) | ((unsigned long long)pk2(o.z, o.w) << 32); }
    }
}

__device__ __forceinline__ void t4_softmax(Frame& F) {
    const float* S = (const float*)(F.ws + WS_S); bf16* P = (bf16*)(F.ws + WS_P); const int lane = F.lane;
    const int gw = F.vcu * NWAVES + F.wave, NGW = F.G * NWAVES;
    for (int r = gw; r < M * 4; r += NGW) {
        f32x4 v = ((const GAS f32x4*)(S + (size_t)r * 256))[lane];
        const float mx = wave_max(fmaxf(fmaxf(v.x, v.y), fmaxf(v.z, v.w)));
        v.x = __builtin_amdgcn_exp2f(v.x - mx); v.y = __builtin_amdgcn_exp2f(v.y - mx); v.z = __builtin_amdgcn_exp2f(v.z - mx); v.w = __builtin_amdgcn_exp2f(v.w - mx);
        const float rs = 1.0f / wave_sum((v.x + v.y) + (v.z + v.w));
        ((GAS unsigned long long*)(P + (size_t)r * 256))[lane] = (unsigned long long)pk2(v.x * rs, v.y * rs) | ((unsigned long long)pk2(v.z * rs, v.w * rs) << 32);
    }
}

__device__ __forceinline__ void t5b_router(Frame& F, const Ins& I) {
    unsigned char* ws = F.ws; const int lane = F.lane, fr = lane & 15, fq = lane >> 4;
    const float* X2 = (const float*)(ws + WS_X2); const float* wrT = (const float*)(ws + WS_TAB) + TB_WRT;
    int* list = (int*)(ws + WS_LIST); int* sel_e = (int*)(ws + WS_SEL); int* sel_pos = sel_e + M * 4; float* sel_g = (float*)(sel_pos + M * 4);
    LAS float* lg = (LAS float*)(F.lds + RING_OFF + F.wave * 16384);
    for (int blk = F.wave * F.G + F.vcu; blk < M / 16; blk += NWAVES * F.G) {
        const int r0 = blk * 16;
        const GAS f32x4* ap = (const GAS f32x4*)(X2 + (size_t)(r0 + fr) * D + fq * 256);
        const GAS f32x4* b0p = (const GAS f32x4*)(wrT + (size_t)fr * D + fq * 256);
        const GAS f32x4* b1p = (const GAS f32x4*)(wrT + (size_t)(16 + fr) * D + fq * 256);
        f32x4 acc0 = {0.f, 0.f, 0.f, 0.f}, acc1 = {0.f, 0.f, 0.f, 0.f};
#pragma unroll 4
        for (int ks = 0; ks < 64; ++ks) {
            const f32x4 a = ap[ks], b0 = b0p[ks], b1 = b1p[ks];
            acc0 = __builtin_amdgcn_mfma_f32_16x16x4f32(a.x, b0.x, acc0, 0, 0, 0); acc1 = __builtin_amdgcn_mfma_f32_16x16x4f32(a.x, b1.x, acc1, 0, 0, 0);
            acc0 = __builtin_amdgcn_mfma_f32_16x16x4f32(a.y, b0.y, acc0, 0, 0, 0); acc1 = __builtin_amdgcn_mfma_f32_16x16x4f32(a.y, b1.y, acc1, 0, 0, 0);
            acc0 = __builtin_amdgcn_mfma_f32_16x16x4f32(a.z, b0.z, acc0, 0, 0, 0); acc1 = __builtin_amdgcn_mfma_f32_16x16x4f32(a.z, b1.z, acc1, 0, 0, 0);
            acc0 = __builtin_amdgcn_mfma_f32_16x16x4f32(a.w, b0.w, acc0, 0, 0, 0); acc1 = __builtin_amdgcn_mfma_f32_16x16x4f32(a.w, b1.w, acc1, 0, 0, 0);
        }
#pragma unroll
        for (int r = 0; r < 4; ++r) { lg[(4 * fq + r) * 33 + fr] = acc0[r]; lg[(4 * fq + r) * 33 + 16 + fr] = acc1[r]; }
        LDS_WAIT(); asm volatile("" ::: "memory");
        if (lane < 16) {
            const int t = r0 + lane;
            float l[NE];
#pragma unroll
            for (int e = 0; e < NE; ++e) l[e] = lg[lane * 33 + e] + I.p[19][e];
            int sel[TOPK]; float sv[TOPK];
#pragma unroll
            for (int k = 0; k < TOPK; ++k) {
                float best = -INFINITY; int bi = 0;
#pragma unroll
                for (int e = 0; e < NE; ++e) { const bool taken = (k > 0 && sel[0] == e) || (k > 1 && sel[1] == e) || (k > 2 && sel[2] == e); if (!taken && l[e] > best) { best = l[e]; bi = e; } }
                sel[k] = bi; sv[k] = best;
            }
            float ex[TOPK], sum = 0.f;
#pragma unroll
            for (int k = 0; k < TOPK; ++k) { ex[k] = expf(sv[k] - sv[0]); sum += ex[k]; }
            const float rs = 1.0f / sum;
#pragma unroll
            for (int k = 0; k < TOPK; ++k) {
                const int pos = (int)__hip_atomic_fetch_add((unsigned*)(F.ctl + CW_CNT + sel[k]), 1u, __ATOMIC_RELAXED, __HIP_MEMORY_SCOPE_AGENT);
                list[(size_t)sel[k] * CAP + pos] = t;
                sel_e[t * 4 + k] = sel[k]; sel_pos[t * 4 + k] = pos; sel_g[t * 4 + k] = ex[k] * rs;
            }
        }
        LDS_WAIT(); asm volatile("" ::: "memory");
    }
}

__device__ __forceinline__ void moe_tables(Frame& F) {
    LAS int* tileE = (LAS int*)(F.lds + TILE_OFF); LAS int* tbase = tileE + 320; LAS int* cntS = tbase + 32; LAS int* Tp = cntS + 32;
    __syncthreads();
    if (F.tid < 32) cntS[F.tid] = (int)__hip_atomic_load((unsigned*)(F.ctl + CW_CNT + F.tid), __ATOMIC_RELAXED, __HIP_MEMORY_SCOPE_AGENT);
    __syncthreads();
    if (F.tid == 0) { int a = 0; for (int e = 0; e < NE; ++e) { tbase[e] = a; const int n = (cntS[e] + 255) >> 8; for (int j = 0; j < n; ++j) tileE[a + j] = e; a += n; } *Tp = a; }
    __syncthreads();
}
struct SchedGU {
    int vcu, T; LAS unsigned char* lds; const char* x2b; const char* wgu;
    __device__ __forceinline__ bool next(int i, pg8::Unit& u) const {
        const int tt = i * 32 + (vcu >> 3); if (tt >= T || i >= 12) return false;
        const int e = __builtin_amdgcn_readfirstlane(((const LAS int*)(lds + TILE_OFF))[tt]), pn = vcu & 7;
        u.A = x2b; u.B = wgu + ((size_t)e * 2048 + (size_t)pn * 256) * 1024; u.orow = tt * 256; u.ocol = pn * 128; u.O = nullptr; u.ldo = 0; u.aux = e; u.gidx = IDX_OFF + i * 1024; return true;
    }
};
struct SchedDown {
    int vcu, T; LAS unsigned char* lds; const char* h; const char* wd;
    __device__ __forceinline__ bool next(int i, pg8::Unit& u) const {
        const int tt = i * 64 + (vcu >> 2); if (tt >= T) return false;
        const int e = __builtin_amdgcn_readfirstlane(((const LAS int*)(lds + TILE_OFF))[tt]), pn = vcu & 3;
        u.A = h + (size_t)tt * 256 * 1024; u.B = wd + ((size_t)e * 1024 + (size_t)pn * 256) * 1024; u.orow = tt * 256; u.ocol = pn * 256; u.O = nullptr; u.ldo = 0; u.aux = e; u.gidx = 0; return true;
    }
};

__device__ __forceinline__ void t6_combine_ln(Frame& F, const Ins& I, float* out) {
    unsigned char* ws = F.ws; const int lane = F.lane;
    const float* X2 = (const float*)(ws + WS_X2); const bf16* Y = (const bf16*)(ws + WS_Y);
    const int* sel_e = (const int*)(ws + WS_SEL); const int* sel_pos = sel_e + M * 4; const float* sel_g = (const float*)(sel_pos + M * 4);
    const LAS int* tbase = (const LAS int*)(F.lds + TILE_OFF) + 320;
    const int gw = F.vcu * NWAVES + F.wave, NGW = F.G * NWAVES;
    f32x4 gg[4], bb[4];
#pragma unroll
    for (int j = 0; j < 4; ++j) { gg[j] = ((const GAS f32x4*)I.p[26])[lane + 64 * j]; bb[j] = ((const GAS f32x4*)I.p[27])[lane + 64 * j]; }
    for (int t = gw; t < M; t += NGW) {
        const GAS f32x4* xr = (const GAS f32x4*)(X2 + (size_t)t * D) + lane;
        f32x4 v[4];
#pragma unroll
        for (int j = 0; j < 4; ++j) v[j] = xr[64 * j] * ALPHA;
#pragma unroll
        for (int k = 0; k < TOPK; ++k) {
            const int e = sel_e[t * 4 + k], pos = sel_pos[t * 4 + k]; const float gt = sel_g[t * 4 + k];
            const GAS unsigned long long* yr = (const GAS unsigned long long*)(Y + ((size_t)tbase[e] * 256 + pos) * D) + lane;
#pragma unroll
            for (int j = 0; j < 4; ++j) { const unsigned long long w = yr[64 * j]; const unsigned lo = (unsigned)w, hi = (unsigned)(w >> 32);
                v[j].x += gt * __uint_as_float(lo << 16); v[j].y += gt * __uint_as_float(lo & 0xffff0000u); v[j].z += gt * __uint_as_float(hi << 16); v[j].w += gt * __uint_as_float(hi & 0xffff0000u); }
        }
        float s = 0.f;
#pragma unroll
        for (int j = 0; j < 4; ++j) s += (v[j].x + v[j].y) + (v[j].z + v[j].w);
        const float mean = wave_sum(s) * (1.f / D); float s2 = 0.f;
#pragma unroll
        for (int j = 0; j < 4; ++j) { v[j] = v[j] - mean; s2 += (v[j].x * v[j].x + v[j].y * v[j].y) + (v[j].z * v[j].z + v[j].w * v[j].w); }
        const float rstd = 1.f / sqrtf(wave_sum(s2) * (1.f / D) + LN_EPS);
        GAS f32x4* orow = (GAS f32x4*)(out + (size_t)t * D) + lane;
#pragma unroll
        for (int j = 0; j < 4; ++j) orow[64 * j] = v[j] * rstd * gg[j] + bb[j];
    }
}

struct Args { const float* in[28]; float* out; unsigned char* ws; int ph_lo, ph_hi, li, pad; };
__global__ void __launch_bounds__(NWAVES * 64, 2) mk_fwd(Args args) {
    extern __shared__ __attribute__((aligned(16))) unsigned char lds[];
    Frame F;
    F.lds = (LAS unsigned char*)lds;
    F.MISC = (volatile LAS unsigned*)(F.lds + MISC_OFF);
    F.tid = threadIdx.x; F.lane = F.tid & 63; F.wave = __builtin_amdgcn_readfirstlane(F.tid >> 6);
    F.G = gridDim.x; { const int bx = blockIdx.x; F.vcu = (F.G % 8 == 0) ? (bx % 8) * (F.G / 8) + bx / 8 : bx; }
    F.ws = args.ws; F.ctl = (gu32*)(args.ws + WS_CTL);
    unsigned char* ws = args.ws;
    Ins I;
#pragma unroll
    for (int i = 0; i < 28; ++i) I.p[i] = args.in[i];
    for (int u = F.tid; u < (LDS_BYTES - LDSCTL_OFF) / 4; u += NWAVES * 64) ((LAS unsigned*)(F.lds + LDSCTL_OFF))[u] = 0u;
    __syncthreads();
    const int lo = args.ph_lo, hi = args.ph_hi;
    XcdBarrier bar; bar.bar = (unsigned*)(F.ctl + CW_BAR) + args.li * XCD_BAR_WORDS; bar.x = 0; bar.st = nullptr;
    if (hi - lo > 1) bar = xcd_barrier_post((unsigned*)(F.ctl + CW_BAR) + args.li * XCD_BAR_WORDS, F.MISC + 8);
#define IN(k) (lo <= (k) && (k) < hi)
#ifndef REPMASK
#define REPMASK 0
#endif
#define PH(k, ...) do { if (IN(k)) { __VA_ARGS__ } if ((REPMASK >> (k)) & 1) { if (hi - lo > 1) xcd_barrier(bar); if (IN(k)) { __VA_ARGS__ } } } while (0)
#define SEAM(k) do { if (IN(k) && IN((k) + 1)) xcd_barrier(bar); } while (0)
    LAS unsigned char* ring = F.lds + RING_OFF;

    PH(0,  p0_prologue(F, I); ); SEAM(0);
    PH(1,
        pg8::Gemm g{2 * D, 2 * D, 2 * D}; SchedP1 S{F.G, (int)blockIdx.x, (const char*)(ws + WS_XB), (const char*)(ws + WS_WIN), (const char*)(ws + WS_MEMB), (const char*)(ws + WS_WKV), (bf16*)(ws + WS_HRAW), (bf16*)(ws + WS_MEMK), (bf16*)(ws + WS_MEMVT)};
        pg8::EpiBf16 E{nullptr, 0, nullptr, 0, 1.0f};
        pg8::gemm_phase<pg8::EpiBf16, SchedP1, true, false>(ring, F.lds, g, S, E);
    ); SEAM(1);
    PH(2,  t1_norm_rope(F, I); ); SEAM(2);
    PH(3,
        for (int i = 0;; ++i) { attn_body::AttnPtrs P; int qb; if (!attn_unit_ptrs(ws, (long)i * F.G + F.vcu, P, qb)) break; attn_body::attn_unit<8>(qb, P, (char*)lds + RING_OFF); }
    ); SEAM(3);
    PH(4,  t2_diff_combine(F, I); ); SEAM(4);
    PH(5,
        pg8::Gemm g{2 * D, 2 * D, 2 * D}; SchedPlain S{M / 256, 4, (M / 256) * 4, F.G, (int)blockIdx.x, (const char*)(ws + WS_AO), (const char*)(ws + WS_WMIX), (size_t)256 * 2048, (size_t)256 * 2048};
        pg8::EpiF32 E{(float*)(ws + WS_X1), I.p[0], D, ALPHA, 1.0f};
        pg8::gemm_phase<pg8::EpiF32, SchedPlain, true, false>(ring, F.lds, g, S, E);
    ); SEAM(5);
    PH(6,  ln_rows<false>(F, (float*)(ws + WS_X1), (bf16*)(ws + WS_XB), I.p[11], I.p[12]); ); SEAM(6);
    PH(7,
        pg8::Gemm g{2 * D, 2 * D, 2 * D}; SchedPlain S{M / 256, 4, (M / 256) * 4, F.G, (int)blockIdx.x, (const char*)(ws + WS_XB), (const char*)(ws + WS_WQ), (size_t)256 * 2048, (size_t)256 * 2048};
        pg8::EpiBf16 E{(bf16*)(ws + WS_QM), D, nullptr, 0, C2M};
        pg8::gemm_phase<pg8::EpiBf16, SchedPlain, true, false>(ring, F.lds, g, S, E);
    ); SEAM(7);
    PH(8,
        struct SchedS { int G, c; const char* qm; const char* mk_;
            __device__ __forceinline__ bool next(int i, pg8::Unit& u) const { const int L = i * G + c; if (L >= 256) return false; const int b = L >> 5, h = (L >> 3) & 3, q = L & 7;
                u.A = qm + ((size_t)(b * SEQ + q * 256) * D + h * 256) * 2; u.B = mk_ + ((size_t)(b * MEMT) * D + h * 256) * 2; u.orow = b * SEQ + q * 256; u.ocol = h * 256; u.O = nullptr; u.ldo = 0; u.aux = 0; u.gidx = 0; return true; } };
        pg8::Gemm g{2 * D, 2 * D, 512}; SchedS S{F.G, F.vcu, (const char*)(ws + WS_QM), (const char*)(ws + WS_MEMK)};
        pg8::EpiF32 E{(float*)(ws + WS_S), nullptr, D, 0.f, 1.0f};
        pg8::gemm_phase<pg8::EpiF32, SchedS, true, false>(ring, F.lds, g, S, E);
    ); SEAM(8);
    PH(9,  t4_softmax(F); ); SEAM(9);
    PH(10,
        struct SchedPV { int G, c; const char* p; const char* vt;
            __device__ __forceinline__ bool next(int i, pg8::Unit& u) const { const int L = i * G + c; if (L >= 256) return false; const int b = L >> 5, h = (L >> 3) & 3, q = L & 7;
                u.A = p + ((size_t)(b * SEQ + q * 256) * D + h * 256) * 2; u.B = vt + ((size_t)(b * 1024 + h * 256) * 256) * 2; u.orow = b * SEQ + q * 256; u.ocol = h * 256; u.O = nullptr; u.ldo = 0; u.aux = 0; u.gidx = 0; return true; } };
        pg8::Gemm g{2 * D, 512, 512}; SchedPV S{F.G, F.vcu, (const char*)(ws + WS_P), (const char*)(ws + WS_MEMVT)};
        pg8::EpiBf16 E{(bf16*)(ws + WS_XO), D, nullptr, 0, 1.0f};
        pg8::gemm_phase<pg8::EpiBf16, SchedPV, true, false>(ring, F.lds, g, S, E);
    ); SEAM(10);
    PH(11,
        pg8::Gemm g{2 * D, 2 * D, 2 * D}; SchedPlain S{M / 256, 4, (M / 256) * 4, F.G, (int)blockIdx.x, (const char*)(ws + WS_XO), (const char*)(ws + WS_WO), (size_t)256 * 2048, (size_t)256 * 2048};
        pg8::EpiF32 E{(float*)(ws + WS_X2), (const float*)(ws + WS_X1), D, ALPHA, 1.0f};
        pg8::gemm_phase<pg8::EpiF32, SchedPlain, true, false>(ring, F.lds, g, S, E);
    ); SEAM(11);
    PH(12,  ln_rows<true>(F, (float*)(ws + WS_X2), (bf16*)(ws + WS_XB), I.p[16], I.p[17]); ); SEAM(12);
    PH(13,  t5b_router(F, I); ); SEAM(13);
    PH(14,
        moe_tables(F);
        const LAS int* tileE = (const LAS int*)(F.lds + TILE_OFF); const LAS int* tbase = tileE + 320; const LAS int* cntS = tbase + 32; const int T = __builtin_amdgcn_readfirstlane(tbase[64]);
        const int* list = (const int*)(ws + WS_LIST);
        for (int i = 0; i < 12; ++i) { const int tt = i * 32 + (F.vcu >> 3); if (tt >= T) break;
            if (F.tid < 256) { const int e = tileE[tt], j = (tt - tbase[e]) * 256 + F.tid; ((LAS int*)(F.lds + IDX_OFF))[i * 256 + F.tid] = list[(size_t)e * CAP + (j < cntS[e] ? j : 0)]; } }
        __syncthreads();
        pg8::Gemm g{D, D, D};     SchedGU S{F.vcu, T, F.lds, (const char*)(ws + WS_XB), (const char*)(ws + WS_WGU)};
        pg8::EpiSwiglu E{ws + WS_H, D, I.p[21], I.p[23], 1.0f / WSCALE};
        pg8::gemm_phase<pg8::EpiSwiglu, SchedGU, true, true, true>(ring, F.lds, g, S, E);
    ); SEAM(14);
    PH(15,
        moe_tables(F);
        const int T = __builtin_amdgcn_readfirstlane(((const LAS int*)(F.lds + TILE_OFF))[320 + 64]);
        pg8::Gemm g{D, D, D};     SchedDown S{F.vcu, T, F.lds, (const char*)(ws + WS_H), (const char*)(ws + WS_WD)};
        pg8::EpiBf16 E{(bf16*)(ws + WS_Y), D, I.p[25], D, 1.0f / WSCALE};
        pg8::gemm_phase<pg8::EpiBf16, SchedDown, true, false, true>(ring, F.lds, g, S, E);
    ); SEAM(15);
    PH(16,  moe_tables(F); t6_combine_ln(F, I, args.out); );
#undef IN
#undef SEAM
}
#ifndef DBG_CUT
#define DBG_CUT 0
#endif
#if DBG_CUT
namespace v0 {
constexpr int NB = 8, SEQ = 2048, DM = 1024, NTOK = NB * SEQ, MEMT = 256, DIN = 2304, NE = 32, TOPK = 4, CAP = NTOK;
constexpr float ALPHA = 1.189207115002721f;
constexpr float LN_EPS = 1e-5f, RMS_EPS = 1e-6f;
constexpr float LAMBDA_INIT = 0.2f;

__device__ __forceinline__ float wave_sum(float v) {
#pragma unroll
    for (int o = 1; o < 64; o <<= 1) v += __shfl_xor(v, o);
    return v;
}
__device__ __forceinline__ float wave_max(float v) {
#pragma unroll
    for (int o = 1; o < 64; o <<= 1) v = fmaxf(v, __shfl_xor(v, o));
    return v;
}

struct GemmArgs {
    const float* A; const float* B; const float* B2; float* C;
    const float* bias; const float* bias2; const float* R;
    const int* rowidx; const int* Mdev; const int* offdev; const float* gate;
    float alpha;
    int M, N, K, lda, ldb, ldc, transB, nz2, aoff_dev, coff_dev;
    long a1, a2, b1, b2, c1, c2, bias1, idx1;
};

template <int MODE>
__global__ void __launch_bounds__(256) k_gemm(GemmArgs g) {
    __shared__ float As[16][68];
    __shared__ float Bs[16][68];
    __shared__ float Bs2[MODE == 2 ? 16 : 1][68];
    const int z = blockIdx.z, z1 = z / g.nz2, z2 = z % g.nz2;
    const int M = g.Mdev ? g.Mdev[z] : g.M;
    const int m0 = blockIdx.y * 64, n0 = blockIdx.x * 64;
    if (m0 >= M) return;
    const float* A = g.A + z1 * g.a1 + z2 * g.a2;
    const float* B = g.B + z1 * g.b1 + z2 * g.b2;
    const float* B2 = MODE == 2 ? g.B2 + z1 * g.b1 + z2 * g.b2 : nullptr;
    float* C = g.C + z1 * g.c1 + z2 * g.c2;
    const long doff = g.offdev ? (long)g.offdev[z] : 0;
    const long aoff = g.aoff_dev ? doff : 0, coff = g.coff_dev ? doff : 0;
    const int* idx = g.rowidx ? g.rowidx + (long)z * g.idx1 : nullptr;
    const int tid = threadIdx.x, tx = tid & 15, ty = tid >> 4;
    float acc[4][4], acc2[4][4];
#pragma unroll
    for (int i = 0; i < 4; ++i)
#pragma unroll
        for (int j = 0; j < 4; ++j) { acc[i][j] = 0.f; acc2[i][j] = 0.f; }
    for (int k0 = 0; k0 < g.K; k0 += 16) {
        {
            const int r = tid >> 2, kq = (tid & 3) * 4, m = m0 + r;
            float4 v = make_float4(0.f, 0.f, 0.f, 0.f);
            if (m < M) { const long row = (idx && MODE != 3) ? (long)idx[m] : (aoff + m); v = *(const float4*)(A + row * g.lda + k0 + kq); }
            As[kq + 0][r] = v.x; As[kq + 1][r] = v.y; As[kq + 2][r] = v.z; As[kq + 3][r] = v.w;
        }
        if (g.transB) {
            const int n = tid >> 2, kq = (tid & 3) * 4;
            float4 v = make_float4(0.f, 0.f, 0.f, 0.f);
            if (n0 + n < g.N) v = *(const float4*)(B + (long)(n0 + n) * g.ldb + k0 + kq);
            Bs[kq + 0][n] = v.x; Bs[kq + 1][n] = v.y; Bs[kq + 2][n] = v.z; Bs[kq + 3][n] = v.w;
        } else {
            const int k = tid >> 4, nq = (tid & 15) * 4;
            float4 v = make_float4(0.f, 0.f, 0.f, 0.f);
            if (n0 + nq < g.N) v = *(const float4*)(B + (long)(k0 + k) * g.ldb + n0 + nq);
            Bs[k][nq + 0] = v.x; Bs[k][nq + 1] = v.y; Bs[k][nq + 2] = v.z; Bs[k][nq + 3] = v.w;
            if (MODE == 2) {
                float4 w = *(const float4*)(B2 + (long)(k0 + k) * g.ldb + n0 + nq);
                Bs2[k][nq + 0] = w.x; Bs2[k][nq + 1] = w.y; Bs2[k][nq + 2] = w.z; Bs2[k][nq + 3] = w.w;
            }
        }
        __syncthreads();
#pragma unroll
        for (int kk = 0; kk < 16; ++kk) {
            float a[4], b[4], b2[4];
#pragma unroll
            for (int i = 0; i < 4; ++i) a[i] = As[kk][ty * 4 + i];
#pragma unroll
            for (int j = 0; j < 4; ++j) b[j] = Bs[kk][tx * 4 + j];
            if (MODE == 2) {
#pragma unroll
                for (int j = 0; j < 4; ++j) b2[j] = Bs2[kk][tx * 4 + j];
            }
#pragma unroll
            for (int i = 0; i < 4; ++i)
#pragma unroll
                for (int j = 0; j < 4; ++j) { acc[i][j] += a[i] * b[j]; if (MODE == 2) acc2[i][j] += a[i] * b2[j]; }
        }
        __syncthreads();
    }
    const float* bias = g.bias ? g.bias + (long)z * g.bias1 : nullptr;
    const float* bias2 = (MODE == 2 && g.bias2) ? g.bias2 + (long)z * g.bias1 : nullptr;
#pragma unroll
    for (int i = 0; i < 4; ++i) {
        const int m = m0 + ty * 4 + i;
        if (m >= M) continue;
#pragma unroll
        for (int j = 0; j < 4; ++j) {
            const int n = n0 + tx * 4 + j;
            if (n >= g.N) continue;
            float v = acc[i][j] + (bias ? bias[n] : 0.f);
            if (MODE == 0) { C[(coff + m) * g.ldc + n] = v; }
            else if (MODE == 1) { C[(coff + m) * g.ldc + n] = g.alpha * g.R[(long)m * g.ldc + n] + v; }
            else if (MODE == 2) {
                float gg = fminf(v, 7.0f);
                float uu = acc2[i][j] + (bias2 ? bias2[n] : 0.f);
                uu = fminf(fmaxf(uu, -7.0f), 7.0f);
                const float sg = 1.0f / (1.0f + expf(-1.702f * gg));
                C[(coff + m) * g.ldc + n] = gg * sg * (uu + 1.0f);
            } else if (MODE == 3) {
                const int tok = idx[m];
                const float gt = g.gate[(long)z * g.idx1 + m];
                atomicAdd(&C[(long)tok * g.ldc + n], gt * v);
            } else { C[(coff + m) * g.ldc + n] = v * g.alpha; }
        }
    }
}

__global__ void __launch_bounds__(256) k_norm_rope(const float* __restrict__ h, const float* __restrict__ gq, const float* __restrict__ gk,
                                                   float* QA, float* KA, float* QB, float* KB) {
    const int lane = threadIdx.x & 63, w = threadIdx.x >> 6;
    const long item = (long)blockIdx.x * 4 + w;
    if (item >= (long)NTOK * 26) return;
    const int t = (int)(item / 26), slot = (int)(item % 26), s = t % SEQ;
    const float* hr = h + (long)t * DIN;
    if (slot < 10) {
        const bool isq = slot < 8;
        const int col0 = isq ? slot * 64 : 512 + (slot - 8) * 64;
        const float v = hr[col0 + lane];
        const float ss = wave_sum(v * v);
        const float y = v * (1.0f / sqrtf(ss * (1.0f / 64.0f) + RMS_EPS)) * (isq ? gq[lane] : gk[lane]);
        const int sub = lane >> 5, j = lane & 31, i = j & 15;
        const int pos = sub == 0 ? (s >> 6) : (s & 63);
        const float inv = powf(10000.0f, -(float)(2 * i) / 32.0f);
        const float ang = (float)pos * inv;
        const float c = cosf(ang), sn = sinf(ang);
        const float p = __shfl_xor(y, 16);
        const float o = (j < 16) ? (y * c - p * sn) : (y * c + p * sn);
        if (isq) QA[(long)t * 512 + slot * 64 + lane] = o; else KA[(long)t * 128 + (slot - 8) * 64 + lane] = o;
    } else {
        const bool isq = slot < 18;
        const int hc = isq ? slot - 10 : slot - 18;
        const int col0 = (isq ? 768 : 1280) + hc * 64;
        const float v = hr[col0 + lane];
        const int i = lane & 31;
        const float inv = powf(10000.0f, -(float)(2 * i) / 64.0f);
        const float ang = (float)s * inv;
        const float c = cosf(ang), sn = sinf(ang);
        const float p = __shfl_xor(v, 32);
        const float o = (lane < 32) ? (v * c - p * sn) : (v * c + p * sn);
        if (isq) QB[(long)t * 512 + hc * 64 + lane] = o; else KB[(long)t * 512 + hc * 64 + lane] = o;
    }
}

template <int DV>
__global__ void __launch_bounds__(64) k_attn(const float* __restrict__ Q, int ldq, const float* __restrict__ K, int ldk, int kgroup,
                                             const float* __restrict__ V, int ldv, int vgroup, int vstride, float* O, int diffmode, float scale) {
    __shared__ float Ks[32][64];
    __shared__ float Vs[32][DV];
    const int lane = threadIdx.x, y = blockIdx.y, b = blockIdx.z;
    const long t = (long)b * SEQ + blockIdx.x * 64 + lane;
    const float* qp = Q + t * ldq + y * 64;
    const float* kb = K + (long)b * SEQ * ldk + (y / kgroup) * 64;
    const float* vb = V + (long)b * SEQ * ldv + (y / vgroup) * vstride;
    float q[64], o[DV];
#pragma unroll
    for (int d = 0; d < 64; d += 4) { const float4 v = *(const float4*)(qp + d); q[d] = v.x * scale; q[d + 1] = v.y * scale; q[d + 2] = v.z * scale; q[d + 3] = v.w * scale; }
#pragma unroll
    for (int d = 0; d < DV; ++d) o[d] = 0.f;
    float m = -INFINITY, l = 0.f;
    for (int kt = 0; kt < SEQ; kt += 32) {
        __syncthreads();
#pragma unroll
        for (int i = 0; i < 8; ++i) { const int e = i * 64 + lane, r = e >> 4, c4 = (e & 15) * 4; *(float4*)&Ks[r][c4] = *(const float4*)(kb + (long)(kt + r) * ldk + c4); }
#pragma unroll
        for (int i = 0; i < DV / 8; ++i) { const int e = i * 64 + lane, r = e / (DV / 4), c4 = (e % (DV / 4)) * 4; *(float4*)&Vs[r][c4] = *(const float4*)(vb + (long)(kt + r) * ldv + c4); }
        __syncthreads();
        for (int j = 0; j < 32; ++j) {
            float s = 0.f;
#pragma unroll
            for (int d = 0; d < 64; d += 4) { const float4 kv = *(const float4*)&Ks[j][d]; s += q[d] * kv.x + q[d + 1] * kv.y + q[d + 2] * kv.z + q[d + 3] * kv.w; }
            const float mn = fmaxf(m, s);
            const float corr = expf(m - mn), p = expf(s - mn);
            l = l * corr + p; m = mn;
#pragma unroll
            for (int d = 0; d < DV; d += 4) { const float4 vv = *(const float4*)&Vs[j][d];
                o[d] = o[d] * corr + p * vv.x; o[d + 1] = o[d + 1] * corr + p * vv.y; o[d + 2] = o[d + 2] * corr + p * vv.z; o[d + 3] = o[d + 3] * corr + p * vv.w; }
        }
    }
    const float rl = 1.0f / l;
    float* op;
    if (diffmode) op = O + (long)(y & 1) * ((long)NTOK * 512) + t * 512 + (y >> 1) * 128;
    else op = O + t * 1024 + y * 64;
#pragma unroll
    for (int d = 0; d < DV; d += 4) *(float4*)(op + d) = make_float4(o[d] * rl, o[d + 1] * rl, o[d + 2] * rl, o[d + 3] * rl);
}

__global__ void __launch_bounds__(256) k_diff_combine(const float* __restrict__ OT, const float* lq1, const float* lk1, const float* lq2, const float* lk2,
                                                      const float* __restrict__ subg, float* AO) {
    const int lane = threadIdx.x & 63, w = threadIdx.x >> 6;
    const long item = (long)blockIdx.x * 4 + w;
    if (item >= (long)NTOK * 4) return;
    const float lam = expf(wave_sum(lq1[lane] * lk1[lane])) - expf(wave_sum(lq2[lane] * lk2[lane])) + LAMBDA_INIT;
    const int t = (int)(item >> 2), hh = (int)(item & 3);
    const float* o1 = OT + (long)t * 512 + hh * 128;
    const float* o2 = o1 + (long)NTOK * 512;
    const float v0 = o1[lane] - lam * o2[lane], v1 = o1[lane + 64] - lam * o2[lane + 64];
    const float ss = wave_sum(v0 * v0 + v1 * v1);
    const float r = 1.0f / sqrtf(ss * (1.0f / 128.0f) + RMS_EPS);
    float* out = AO + (long)t * 1024 + 512 + hh * 128;
    out[lane] = v0 * r * subg[lane] * (1.0f - LAMBDA_INIT);
    out[lane + 64] = v1 * r * subg[lane + 64] * (1.0f - LAMBDA_INIT);
}

__global__ void __launch_bounds__(256) k_ln(const float* in, const float* __restrict__ g, const float* __restrict__ bta, float* out, float* out2, float a2, int rows) {
    const int lane = threadIdx.x & 63, w = threadIdx.x >> 6;
    const int row = blockIdx.x * 4 + w;
    if (row >= rows) return;
    const float4* xr = (const float4*)(in + (long)row * DM) + lane;
    float4 v[4]; float s = 0.f;
#pragma unroll
    for (int j = 0; j < 4; ++j) { v[j] = xr[64 * j]; s += (v[j].x + v[j].y) + (v[j].z + v[j].w); }
    const float mean = wave_sum(s) * (1.0f / DM); float s2 = 0.f;
#pragma unroll
    for (int j = 0; j < 4; ++j) { v[j].x -= mean; v[j].y -= mean; v[j].z -= mean; v[j].w -= mean; s2 += (v[j].x * v[j].x + v[j].y * v[j].y) + (v[j].z * v[j].z + v[j].w * v[j].w); }
    const float rstd = 1.0f / sqrtf(wave_sum(s2) * (1.0f / DM) + LN_EPS);
#pragma unroll
    for (int j = 0; j < 4; ++j) {
        const float4 gg = ((const float4*)g)[lane + 64 * j], bb = ((const float4*)bta)[lane + 64 * j];
        float4 o; o.x = v[j].x * rstd * gg.x + bb.x; o.y = v[j].y * rstd * gg.y + bb.y; o.z = v[j].z * rstd * gg.z + bb.z; o.w = v[j].w * rstd * gg.w + bb.w;
        ((float4*)(out + (long)row * DM))[lane + 64 * j] = o;
        if (out2) ((float4*)(out2 + (long)row * DM))[lane + 64 * j] = make_float4(a2 * o.x, a2 * o.y, a2 * o.z, a2 * o.w);
    }
}

__global__ void __launch_bounds__(256) k_softmax256(float* S, long nrows) {
    const int lane = threadIdx.x & 63, w = threadIdx.x >> 6;
    const long row = (long)blockIdx.x * 4 + w;
    if (row >= nrows) return;
    float4* p = (float4*)(S + row * 256) + lane;
    float4 v = *p;
    const float mx = wave_max(fmaxf(fmaxf(v.x, v.y), fmaxf(v.z, v.w)));
    v.x = expf(v.x - mx); v.y = expf(v.y - mx); v.z = expf(v.z - mx); v.w = expf(v.w - mx);
    const float r = 1.0f / wave_sum((v.x + v.y) + (v.z + v.w));
    v.x *= r; v.y *= r; v.z *= r; v.w *= r;
    *p = v;
}

__global__ void __launch_bounds__(256) k_topk(const float* __restrict__ logits, int* cnt, int* list, float* glist) {
    const int t = blockIdx.x * 256 + threadIdx.x;
    if (t >= NTOK) return;
    float lg[NE];
#pragma unroll
    for (int e = 0; e < NE; e += 4) { const float4 v = *(const float4*)(logits + (long)t * NE + e); lg[e] = v.x; lg[e + 1] = v.y; lg[e + 2] = v.z; lg[e + 3] = v.w; }
    int sel[TOPK]; float sv[TOPK];
#pragma unroll
    for (int k = 0; k < TOPK; ++k) {
        float best = -INFINITY; int bi = 0;
#pragma unroll
        for (int e = 0; e < NE; ++e) { const bool taken = (k > 0 && sel[0] == e) || (k > 1 && sel[1] == e) || (k > 2 && sel[2] == e); if (!taken && lg[e] > best) { best = lg[e]; bi = e; } }
        sel[k] = bi; sv[k] = best;
    }
    const float mx = sv[0];
    float ex[TOPK], sum = 0.f;
#pragma unroll
    for (int k = 0; k < TOPK; ++k) { ex[k] = expf(sv[k] - mx); sum += ex[k]; }
#pragma unroll
    for (int k = 0; k < TOPK; ++k) {
        const int pos = atomicAdd(&cnt[sel[k]], 1);
        list[(long)sel[k] * CAP + pos] = t;
        glist[(long)sel[k] * CAP + pos] = ex[k] / sum;
    }
}
__global__ void k_offsets(const int* cnt, int* off) {
    if (threadIdx.x == 0 && blockIdx.x == 0) { int a = 0; for (int e = 0; e < NE; ++e) { off[e] = a; a += cnt[e]; } }
}
}
#endif

#ifndef DBG_CUT
#define DBG_CUT 0
#endif
#ifndef MK_SPLIT
#define MK_SPLIT 0
#endif

#if DBG_CUT
__global__ void __launch_bounds__(256) k_bf16_to_f32(const unsigned short* in, float* out, long n) {
    const long i = (long)blockIdx.x * 256 + threadIdx.x; if (i < n) out[i] = __uint_as_float((unsigned)in[i] << 16);
}
__global__ void __launch_bounds__(256) k_scale(const float* in, float* out, float a, long n) {
    const long i = (long)blockIdx.x * 256 + threadIdx.x; if (i < n) out[i] = a * in[i];
}
static void v0_tail(int stage, void* const* d_in, float* out, char* ws, hipStream_t stream) {
    using namespace v0;
    constexpr size_t MiB = 1u << 20;
    const float* x = (const float*)d_in[0]; const float* mem = (const float*)d_in[1];
    const float* w_mix = (const float*)d_in[10]; const float* ln1g = (const float*)d_in[11]; const float* ln1b = (const float*)d_in[12];
    const float* w_mq = (const float*)d_in[13]; const float* w_mkv = (const float*)d_in[14]; const float* w_mo = (const float*)d_in[15];
    const float* ln2g = (const float*)d_in[16]; const float* ln2b = (const float*)d_in[17]; const float* w_r = (const float*)d_in[18]; const float* b_r = (const float*)d_in[19];
    const float* w_g = (const float*)d_in[20]; const float* b_g = (const float*)d_in[21]; const float* w_u = (const float*)d_in[22]; const float* b_u = (const float*)d_in[23];
    const float* w_d = (const float*)d_in[24]; const float* b_d = (const float*)d_in[25]; const float* ln3g = (const float*)d_in[26]; const float* ln3b = (const float*)d_in[27];
    float* X1 = (float*)(ws + 0); float* QM = (float*)(ws + 64 * MiB); float* AOf = QM; float* S = (float*)(ws + 128 * MiB); float* XO = (float*)(ws + 192 * MiB);
    float* KV = (float*)(ws + 392 * MiB); float* X2 = (float*)(ws + 448 * MiB); float* Y = (float*)(ws + 256 * MiB); float* HH = (float*)(ws + 0);
    int* cnt = (int*)(ws + 320 * MiB); int* off = cnt + 64; float* logits = (float*)(ws + 321 * MiB); int* list = (int*)(ws + 323 * MiB); float* glist = (float*)(ws + 325 * MiB);
    (void)hipMemsetAsync(cnt, 0, 1024, stream);
    auto gemm0 = [&](int mode, GemmArgs g, dim3 grid) {
        switch (mode) {
            case 0: hipLaunchKernelGGL(k_gemm<0>, grid, dim3(256), 0, stream, g); break;
            case 1: hipLaunchKernelGGL(k_gemm<1>, grid, dim3(256), 0, stream, g); break;
            case 2: hipLaunchKernelGGL(k_gemm<2>, grid, dim3(256), 0, stream, g); break;
            case 3: hipLaunchKernelGGL(k_gemm<3>, grid, dim3(256), 0, stream, g); break;
            default: hipLaunchKernelGGL(k_gemm<4>, grid, dim3(256), 0, stream, g); break;
        }
    };
    if (stage <= 1) {
        { GemmArgs g{}; g.A = AOf; g.B = w_mix; g.C = X1; g.R = x; g.alpha = ALPHA; g.M = NTOK; g.N = DM; g.K = DM; g.lda = DM; g.ldb = DM; g.ldc = DM; g.nz2 = 1; gemm0(1, g, dim3(DM / 64, NTOK / 64, 1)); }
        hipLaunchKernelGGL(k_ln, dim3(NTOK / 4), dim3(256), 0, stream, X1, ln1g, ln1b, X1, (float*)nullptr, 0.f, NTOK);
    }
    if (stage <= 2) {
        { GemmArgs g{}; g.A = mem; g.B = w_mkv; g.C = KV; g.M = NB * MEMT; g.N = 2048; g.K = DM; g.lda = DM; g.ldb = 2048; g.ldc = 2048; g.nz2 = 1; gemm0(0, g, dim3(2048 / 64, NB * MEMT / 64, 1)); }
        { GemmArgs g{}; g.A = X1; g.B = w_mq; g.C = QM; g.M = NTOK; g.N = DM; g.K = DM; g.lda = DM; g.ldb = DM; g.ldc = DM; g.nz2 = 1; gemm0(0, g, dim3(DM / 64, NTOK / 64, 1)); }
        { GemmArgs g{}; g.A = QM; g.B = KV; g.C = S; g.alpha = 0.0625f; g.M = SEQ; g.N = 256; g.K = 256; g.lda = DM; g.ldb = 2048; g.ldc = DM; g.transB = 1; g.nz2 = 4;
          g.a1 = (long)SEQ * DM; g.a2 = 256; g.b1 = (long)MEMT * 2048; g.b2 = 256; g.c1 = (long)SEQ * DM; g.c2 = 256; gemm0(4, g, dim3(4, SEQ / 64, NB * 4)); }
        hipLaunchKernelGGL(k_softmax256, dim3(NTOK * 4 / 4), dim3(256), 0, stream, S, (long)NTOK * 4);
        { GemmArgs g{}; g.A = S; g.B = KV + 1024; g.C = XO; g.M = SEQ; g.N = 256; g.K = 256; g.lda = DM; g.ldb = 2048; g.ldc = DM; g.nz2 = 4;
          g.a1 = (long)SEQ * DM; g.a2 = 256; g.b1 = (long)MEMT * 2048; g.b2 = 256; g.c1 = (long)SEQ * DM; g.c2 = 256; gemm0(0, g, dim3(4, SEQ / 64, NB * 4)); }
        { GemmArgs g{}; g.A = XO; g.B = w_mo; g.C = X2; g.R = X1; g.alpha = ALPHA; g.M = NTOK; g.N = DM; g.K = DM; g.lda = DM; g.ldb = DM; g.ldc = DM; g.nz2 = 1; gemm0(1, g, dim3(DM / 64, NTOK / 64, 1)); }
        hipLaunchKernelGGL(k_ln, dim3(NTOK / 4), dim3(256), 0, stream, X2, ln2g, ln2b, X2, Y, ALPHA, NTOK);
    } else {
        hipLaunchKernelGGL(k_scale, dim3(NTOK * DM / 256), dim3(256), 0, stream, X2, Y, ALPHA, (long)NTOK * DM);
    }
    { GemmArgs g{}; g.A = X2; g.B = w_r; g.C = logits; g.bias = b_r; g.M = NTOK; g.N = NE; g.K = DM; g.lda = DM; g.ldb = NE; g.ldc = NE; g.nz2 = 1; gemm0(0, g, dim3(1, NTOK / 64, 1)); }
    hipLaunchKernelGGL(k_topk, dim3(NTOK / 256), dim3(256), 0, stream, logits, cnt, list, glist);
    hipLaunchKernelGGL(k_offsets, dim3(1), dim3(64), 0, stream, cnt, off);
    { GemmArgs g{}; g.A = X2; g.B = w_g; g.B2 = w_u; g.C = HH; g.bias = b_g; g.bias2 = b_u; g.rowidx = list; g.Mdev = cnt; g.offdev = off; g.coff_dev = 1;
      g.M = NTOK; g.N = DM; g.K = DM; g.lda = DM; g.ldb = DM; g.ldc = DM; g.nz2 = 1; g.b1 = (long)DM * DM; g.bias1 = DM; g.idx1 = CAP; gemm0(2, g, dim3(DM / 64, NTOK / 64, NE)); }
    { GemmArgs g{}; g.A = HH; g.B = w_d; g.C = Y; g.bias = b_d; g.rowidx = list; g.Mdev = cnt; g.offdev = off; g.aoff_dev = 1; g.gate = glist;
      g.M = NTOK; g.N = DM; g.K = DM; g.lda = DM; g.ldb = DM; g.ldc = DM; g.nz2 = 1; g.b1 = (long)DM * DM; g.bias1 = DM; g.idx1 = CAP; gemm0(3, g, dim3(DM / 64, NTOK / 64, NE)); }
    hipLaunchKernelGGL(k_ln, dim3(NTOK / 4), dim3(256), 0, stream, Y, ln3g, ln3b, out, (float*)nullptr, 0.f, NTOK);
}
#endif

extern "C" void kernel_launch(void* const* d_in, const int* in_sizes, int n_in, void* d_out, int out_size, void* d_ws, size_t ws_size, hipStream_t stream) {
    static int grid = 0;
    if (grid == 0) {
        if (n_in != 28 || in_sizes[0] != M * D || out_size != M * D || ws_size < WS_END) { fprintf(stderr, "kernel_launch: unexpected shapes (n_in %d, in0 %d, out %d, ws %zu); nothing launched\n", n_in, n_in > 0 ? in_sizes[0] : -1, out_size, ws_size); grid = -1; return; }
        int dev = 0, cus = 0, per_cu = 0;
        if (hipGetDevice(&dev) != hipSuccess || hipDeviceGetAttribute(&cus, hipDeviceAttributeMultiprocessorCount, dev) != hipSuccess) { grid = -1; return; }
        if (hipFuncSetAttribute((const void*)mk_fwd, hipFuncAttributeMaxDynamicSharedMemorySize, LDS_BYTES) != hipSuccess) { fprintf(stderr, "kernel_launch: hipFuncSetAttribute failed\n"); grid = -1; return; }
        if (hipOccupancyMaxActiveBlocksPerMultiprocessor(&per_cu, (const void*)mk_fwd, NWAVES * 64, LDS_BYTES) != hipSuccess || per_cu < 1) { fprintf(stderr, "kernel_launch: occupancy query reports %d workgroups per CU\n", per_cu); }
        (void)hipGetLastError();
        grid = cus;
        if (grid != 256) fprintf(stderr, "kernel_launch: %d CUs (built for 256)\n", grid);
    }
    if (grid < 0) return;
    if (hipMemsetAsync((char*)d_ws + WS_CTL, 0, CTL_ZERO_BYTES, stream) != hipSuccess) return;
    Args a{};
    for (int i = 0; i < 28; ++i) a.in[i] = (const float*)d_in[i];
    a.out = (float*)d_out; a.ws = (unsigned char*)d_ws;
#if DBG_CUT == 1
    const int last_phase = 5;
#elif DBG_CUT == 2
    const int last_phase = 7;
#elif DBG_CUT == 3
    const int last_phase = 13;
#else
    const int last_phase = NPHASE;
#endif
#if MK_SPLIT
    for (int p = 0; p < last_phase; ++p) { a.ph_lo = p; a.ph_hi = p + 1; a.li = p; hipLaunchKernelGGL(mk_fwd, dim3(grid), dim3(NWAVES * 64), LDS_BYTES, stream, a); }
#else
    a.ph_lo = 0; a.ph_hi = last_phase; a.li = 0; hipLaunchKernelGGL(mk_fwd, dim3(grid), dim3(NWAVES * 64), LDS_BYTES, stream, a);
#endif
#if DBG_CUT
    {
        char* ws = (char*)d_ws; const size_t MiBh = 1u << 20;
#if DBG_CUT == 1
        hipLaunchKernelGGL(k_bf16_to_f32, dim3(M * D / 256), dim3(256), 0, stream, (const unsigned short*)(ws + WS_AO), (float*)(ws + 64 * MiBh), (long)M * D);
#elif DBG_CUT == 2
        (void)hipMemcpyAsync(ws + 0, ws + WS_X1, (size_t)M * D * 4, hipMemcpyDeviceToDevice, stream);
#else
        (void)hipMemcpyAsync(ws + 448 * MiBh, ws + WS_X2, (size_t)M * D * 4, hipMemcpyDeviceToDevice, stream);
#endif
        v0_tail(DBG_CUT, d_in, (float*)d_out, ws, stream);
    }
#endif
}
```

```cpp
#include <hip/hip_runtime.h>
#include <cstdio>
#include <cstdint>
namespace pg8 {
#define PG8_LAS __attribute__((address_space(3)))
typedef unsigned short bf16_t;
typedef short bf16x8 __attribute__((ext_vector_type(8)));
typedef float f32x4 __attribute__((ext_vector_type(4)));
typedef unsigned u32x4 __attribute__((ext_vector_type(4)));
typedef int i32x4 __attribute__((ext_vector_type(4)));
typedef int i32x8 __attribute__((ext_vector_type(8)));
constexpr int BM = 256, BK = 64, HALF = 128, HTB = HALF * BK * 2  , STAGE_BYTES = 8 * HTB, NXCD = 8, WGM = 8;

__host__ __device__ __forceinline__ int lds_byte(int r, int c) { const int st = (r >> 4) * 2 + (c >> 5), rr = r & 15, cc = c & 31, ob = rr * 64 + cc * 2; return st * 1024 + (ob ^ (((ob >> 9) & 1) << 5)); }
__host__ __device__ __forceinline__ void stage_rc(int b, int& R, int& C) { const int st = b / 1024, sb = b % 1024, swz = sb ^ (((sb >> 9) & 1) << 5); R = (st >> 1) * 16 + swz / 64; C = (st & 1) * 32 + (swz % 64) / 2; }
__host__ __device__ __forceinline__ int perm32(int rho) { const int n = rho >> 4, i = rho & 15; return 8 * (i >> 2) + 4 * n + (i & 3); }
__device__ __forceinline__ unsigned cvt_pk_bf16(float lo, float hi) { unsigned r; asm volatile("v_cvt_pk_bf16_f32 %0, %1, %2" : "=v"(r) : "v"(lo), "v"(hi)); return r; }
typedef float f32x2 __attribute__((ext_vector_type(2)));

struct Unit { const char* A; const char* B; void* O; int ldo, orow, ocol, aux, gidx; };
struct Gemm { int lda, ldb, K; };

struct EpiBf16 {
    static constexpr bool PERM = true, AFTER_DRAIN = false;
    bf16_t* O; int ldc; const float* bias; int bstride; float scale;
    __device__ __forceinline__ void operator()(const f32x4 (&acc)[2][2][4][2], const Unit& u, int wr, int wc, int fr, int fq) const {
        bf16_t* base = O ? O : (bf16_t*)u.O; const int ld = O ? ldc : u.ldo;
        const int row0 = u.orow + wr * 64 + fr, col0 = u.ocol + wc * 32 + 8 * fq;
        f32x4 bv[2][2];
#pragma unroll
        for (int bj = 0; bj < 2; ++bj)
#pragma unroll
            for (int n = 0; n < 2; ++n) bv[bj][n] = bias ? *(const f32x4*)(bias + (size_t)u.aux * bstride + col0 + bj * HALF + 4 * n) : (f32x4){0.f, 0.f, 0.f, 0.f};
#pragma unroll
        for (int ai = 0; ai < 2; ++ai)
#pragma unroll
            for (int m = 0; m < 4; ++m) { bf16_t* rowp = base + (size_t)(row0 + ai * HALF + m * 16) * ld + col0;
#pragma unroll
                for (int bj = 0; bj < 2; ++bj) { f32x4 v0 = acc[ai][bj][m][0] * scale + bv[bj][0], v1 = acc[ai][bj][m][1] * scale + bv[bj][1];
                    u32x4 w; w.x = cvt_pk_bf16(v0[0], v0[1]); w.y = cvt_pk_bf16(v0[2], v0[3]); w.z = cvt_pk_bf16(v1[0], v1[1]); w.w = cvt_pk_bf16(v1[2], v1[3]);
                    *(u32x4*)(rowp + bj * HALF) = w; } }
    }
};
struct EpiF32 {
    static constexpr bool PERM = false, AFTER_DRAIN = false;
    float* out; const float* base; int ldc; float alpha, scale;
    __device__ __forceinline__ void operator()(const f32x4 (&acc)[2][2][4][2], const Unit& u, int wr, int wc, int fr, int fq) const {
        const int col0 = u.ocol + wc * 32 + 4 * fq;
#pragma unroll
        for (int ai = 0; ai < 2; ++ai)
#pragma unroll
            for (int m = 0; m < 4; ++m) { const size_t off = (size_t)(u.orow + ai * HALF + wr * 64 + m * 16 + fr) * ldc + col0;
#pragma unroll
                for (int bj = 0; bj < 2; ++bj)
#pragma unroll
                    for (int n = 0; n < 2; ++n) { f32x4 o = acc[ai][bj][m][n] * scale;
                        if (base) { const f32x4 bs = *(const f32x4*)(base + off + bj * HALF + n * 16); o = o + bs * alpha; }
                        *(f32x4*)(out + off + bj * HALF + n * 16) = o; }
                if (m & 1) asm volatile("" ::: "memory"); }
    }
};

struct EpiSoftmax {
    static constexpr bool PERM = true, AFTER_DRAIN = true;
    bf16_t* P; int ldc;
    __device__ __forceinline__ void fused(f32x4 (&acc)[2][2][4][2], const Unit& u, int wr, int wc, int fr, int fq, PG8_LAS unsigned char* lds, int wid, int lane) const {
        PG8_LAS float* Pm = (PG8_LAS float*)lds; PG8_LAS float* Ps = (PG8_LAS float*)(lds + 4096);
#define PG8_XBAR() do { asm volatile("s_waitcnt lgkmcnt(0)" ::: "memory"); __builtin_amdgcn_s_barrier(); asm volatile("" ::: "memory"); } while (0)
#pragma unroll
        for (int ai = 0; ai < 2; ++ai)
#pragma unroll
            for (int m = 0; m < 4; ++m) { float v = -INFINITY;
#pragma unroll
                for (int bj = 0; bj < 2; ++bj)
#pragma unroll
                    for (int n = 0; n < 2; ++n) { const f32x4 x = acc[ai][bj][m][n]; v = fmaxf(v, fmaxf(fmaxf(x[0], x[1]), fmaxf(x[2], x[3]))); }
                v = fmaxf(v, __shfl_xor(v, 16)); v = fmaxf(v, __shfl_xor(v, 32));
                if (fq == 0) Pm[(ai * HALF + wr * 64 + m * 16 + fr) * 4 + wc] = v; }
        PG8_XBAR();
#pragma unroll
        for (int ai = 0; ai < 2; ++ai)
#pragma unroll
            for (int m = 0; m < 4; ++m) { const int r = ai * HALF + wr * 64 + m * 16 + fr; const f32x4 m4 = *(const PG8_LAS f32x4*)(Pm + r * 4);
                const float mx = fmaxf(fmaxf(m4[0], m4[1]), fmaxf(m4[2], m4[3])); float sum = 0.f;
#pragma unroll
                for (int bj = 0; bj < 2; ++bj)
#pragma unroll
                    for (int n = 0; n < 2; ++n) { f32x4 x = acc[ai][bj][m][n];
                        x[0] = __builtin_amdgcn_exp2f(x[0] - mx); x[1] = __builtin_amdgcn_exp2f(x[1] - mx); x[2] = __builtin_amdgcn_exp2f(x[2] - mx); x[3] = __builtin_amdgcn_exp2f(x[3] - mx);
                        sum += (x[0] + x[1]) + (x[2] + x[3]); acc[ai][bj][m][n] = x; }
                sum += __shfl_xor(sum, 16); sum += __shfl_xor(sum, 32);
                if (fq == 0) Ps[r * 4 + wc] = sum; }
        PG8_XBAR();
        const int col0 = u.ocol + wc * 32 + 8 * fq;
#pragma unroll
        for (int ai = 0; ai < 2; ++ai)
#pragma unroll
            for (int m = 0; m < 4; ++m) { const int r = ai * HALF + wr * 64 + m * 16 + fr; const f32x4 s4 = *(const PG8_LAS f32x4*)(Ps + r * 4);
                const float inv = 1.0f / ((s4[0] + s4[1]) + (s4[2] + s4[3])); bf16_t* rowp = P + (size_t)(u.orow + r) * ldc + col0;
#pragma unroll
                for (int bj = 0; bj < 2; ++bj) { const f32x4 v0 = acc[ai][bj][m][0] * inv, v1 = acc[ai][bj][m][1] * inv;
                    u32x4 w; w.x = cvt_pk_bf16(v0[0], v0[1]); w.y = cvt_pk_bf16(v0[2], v0[3]); w.z = cvt_pk_bf16(v1[0], v1[1]); w.w = cvt_pk_bf16(v1[2], v1[3]);
                    *(u32x4*)(rowp + bj * HALF) = w; } }
#undef PG8_XBAR
    }
};
struct EpiSwiglu {
    static constexpr bool PERM = true, AFTER_DRAIN = false;
    unsigned char* H; int ldc; const float* bg; const float* bu; float ascale;
    __device__ __forceinline__ static float act(float g, float u) {
        g = fminf(g, 7.0f); u = fminf(fmaxf(u, -7.0f), 7.0f);
        const float sg = __builtin_amdgcn_rcpf(1.0f + __builtin_amdgcn_exp2f(-1.702f * 1.4426950408889634f * g));
        return g * sg * (u + 1.0f);
    }
    __device__ __forceinline__ void operator()(const f32x4 (&acc)[2][2][4][2], const Unit& u, int wr, int wc, int fr, int fq) const {
        const int row0 = u.orow + wr * 64 + fr, col0 = u.ocol + wc * 32 + 8 * fq;
        f32x4 bgv[2], buv[2];
#pragma unroll
        for (int n = 0; n < 2; ++n) { bgv[n] = *(const f32x4*)(bg + (size_t)u.aux * 1024 + col0 + 4 * n); buv[n] = *(const f32x4*)(bu + (size_t)u.aux * 1024 + col0 + 4 * n); }
#pragma unroll
        for (int ai = 0; ai < 2; ++ai)
#pragma unroll
            for (int m = 0; m < 4; ++m) { unsigned char* rowp = H + (size_t)(row0 + ai * HALF + m * 16) * ldc + col0;
                const f32x4 g0 = acc[ai][0][m][0] * ascale + bgv[0], g1 = acc[ai][0][m][1] * ascale + bgv[1], u0 = acc[ai][1][m][0] * ascale + buv[0], u1 = acc[ai][1][m][1] * ascale + buv[1];
                unsigned w0 = 0u, w1 = 0u;
                w0 = __builtin_amdgcn_cvt_pk_fp8_f32(act(g0[0], u0[0]), act(g0[1], u0[1]), w0, false); w0 = __builtin_amdgcn_cvt_pk_fp8_f32(act(g0[2], u0[2]), act(g0[3], u0[3]), w0, true);
                w1 = __builtin_amdgcn_cvt_pk_fp8_f32(act(g1[0], u1[0]), act(g1[1], u1[1]), w1, false); w1 = __builtin_amdgcn_cvt_pk_fp8_f32(act(g1[2], u1[2]), act(g1[3], u1[3]), w1, true);
                typedef unsigned u32x2 __attribute__((ext_vector_type(2))); *(u32x2*)rowp = (u32x2){w0, w1}; }
    }
};

__device__ __forceinline__ const char* rfl_ptr(const char* p) { const unsigned long long v = (unsigned long long)p; const unsigned lo = __builtin_amdgcn_readfirstlane((unsigned)v), hi = __builtin_amdgcn_readfirstlane((unsigned)(v >> 32)); return (const char*)(((unsigned long long)hi << 32) | lo); }
template <class Epi, class Sched, bool ALIGN_EPI, bool GATHER, bool FP8 = false>
__device__ __forceinline__ void gemm_phase(PG8_LAS unsigned char* lds, PG8_LAS unsigned char* ldsall, const Gemm g, const Sched& S, const Epi& E) {
    const int tid = threadIdx.x, wid = __builtin_amdgcn_readfirstlane(tid >> 6), lane = tid & 63, wr = wid >> 2, wc = wid & 3, fr = lane & 15, fq = lane >> 4;
    const int K = g.K, nt = K / 128;
    unsigned voffA[2], voffB[2];
#pragma unroll
    for (int i = 0; i < 2; ++i) { int R, C; stage_rc(tid * 16 + i * 8192, R, C); const int Rb = Epi::PERM ? ((R & ~31) + perm32(R & 31)) : R;
        voffA[i] = (unsigned)(R * g.lda + C * 2); voffB[i] = (unsigned)(Rb * g.ldb + C * 2); }
    const size_t kstep = (size_t)128;
    const size_t hstepA = (size_t)HALF * g.lda, hstepB = (size_t)HALF * g.ldb;
    const unsigned ldsw = (unsigned)wid * 1024u;
    const int aoff = lds_byte(wr * 64 + fr, fq * 8), boff = lds_byte(wc * 32 + fr, fq * 8);
    const unsigned lda2 = (unsigned)g.lda;
#define PG8_SA(b, h) (((b) * 2 + (h)) * HTB)
#define PG8_SB(b, h) ((4 + (b) * 2 + (h)) * HTB)
#define PG8_GL(bufoff, base, off32, i_) do { unsigned _o = (off32); const char* _b = (const char*)(base); asm volatile("" : "+v"(_o), "+s"(_b)); __builtin_amdgcn_global_load_lds((const unsigned*)(_b + _o), (PG8_LAS unsigned*)(lds + (bufoff) + ldsw + (i_) * 8192), 16, 0, 0); } while (0)
#define PG8_STAGE_B(bufoff, gbase) do { _Pragma("unroll") for (int _i = 0; _i < 2; ++_i) PG8_GL(bufoff, gbase, voffB[_i], _i); } while (0)
#define PG8_STAGE_A(bufoff, gbase, h, OFFS) do { _Pragma("unroll") for (int _i = 0; _i < 2; ++_i) { \
        if constexpr (GATHER) PG8_GL(bufoff, gbase, OFFS(h, _i), _i); else PG8_GL(bufoff, (const char*)(gbase) + (h) * hstepA, voffA[_i], _i); } } while (0)
#define PG8_OC(h, i) gA[h][i]
#define PG8_ON(h, i) gA[h][i]
#define PG8_RD8(p) __builtin_shufflevector(*(const PG8_LAS i32x4*)(p), *(const PG8_LAS i32x4*)((p) + 1024), 0, 1, 2, 3, 4, 5, 6, 7)
#define PG8_LDA(dst, b, h) do { _Pragma("unroll") for (int m = 0; m < 4; ++m) { if constexpr (FP8) dst##8[m] = PG8_RD8(lds + PG8_SA(b, h) + aoff + m * 2048); else { _Pragma("unroll") for (int k = 0; k < 2; ++k) dst[m][k] = *(const PG8_LAS bf16x8*)(lds + PG8_SA(b, h) + aoff + m * 2048 + k * 1024); } } } while (0)
#define PG8_LDB(dst, b, h) do { _Pragma("unroll") for (int n = 0; n < 2; ++n) { if constexpr (FP8) dst##8[n] = PG8_RD8(lds + PG8_SB(b, h) + boff + n * 2048); else { _Pragma("unroll") for (int k = 0; k < 2; ++k) dst[n][k] = *(const PG8_LAS bf16x8*)(lds + PG8_SB(b, h) + boff + n * 2048 + k * 1024); } } } while (0)
#define PG8_MMA(ai, bj, At, Bt) do { __builtin_amdgcn_s_setprio(1); _Pragma("unroll") for (int m = 0; m < 4; ++m) _Pragma("unroll") for (int n = 0; n < 2; ++n) { \
        if constexpr (FP8) acc[ai][bj][m][n] = __builtin_amdgcn_mfma_scale_f32_16x16x128_f8f6f4(Bt##8[n], At##8[m], acc[ai][bj][m][n], 0, 0, 0, 0x7f7f7f7f, 0, 0x7f7f7f7f); \
        else { _Pragma("unroll") for (int k = 0; k < 2; ++k) acc[ai][bj][m][n] = __builtin_amdgcn_mfma_f32_16x16x32_bf16(Bt[n][k], At[m][k], acc[ai][bj][m][n], 0, 0, 0); } } __builtin_amdgcn_s_setprio(0); } while (0)
#define PG8_WAIT_V(n) asm volatile("s_waitcnt vmcnt(" #n ")" ::: "memory")
#define PG8_WAIT_L(n) asm volatile("s_waitcnt lgkmcnt(" #n ")" ::: "memory")
#define PG8_BAR __builtin_amdgcn_s_barrier()
#define PG8_SCHED __builtin_amdgcn_sched_barrier(0)
#define PG8_GIDX(dst, un) do { if constexpr (GATHER) { const PG8_LAS int* _ix = (const PG8_LAS int*)(ldsall + (un).gidx); _Pragma("unroll") for (int _h = 0; _h < 2; ++_h) _Pragma("unroll") for (int _i = 0; _i < 2; ++_i) { \
        int _R, _C; stage_rc(tid * 16 + _i * 8192, _R, _C); dst[_h][_i] = (unsigned)_ix[_h * HALF + _R] * lda2 + (unsigned)(_C * 2); } } } while (0)
    Unit cur, nxt; int ui = 0;
    if (!S.next(0, cur)) return;
    f32x4 acc[2][2][4][2];
#pragma unroll
    for (int a = 0; a < 2; ++a)
#pragma unroll
        for (int b = 0; b < 2; ++b)
#pragma unroll
            for (int m = 0; m < 4; ++m)
#pragma unroll
                for (int n = 0; n < 2; ++n) acc[a][b][m][n] = (f32x4){0.f, 0.f, 0.f, 0.f};
    bf16x8 At[4][2], B0[2][2], B1[2][2]; i32x8 At8[4], B08[2], B18[2];
    unsigned gA[2][2] = {{0u, 0u}, {0u, 0u}};
    PG8_GIDX(gA, cur);
    const char* cA = rfl_ptr(cur.A); const char* cB = rfl_ptr(cur.B);
    PG8_STAGE_B(PG8_SB(0, 0), cB); PG8_STAGE_B(PG8_SB(0, 1), cB + hstepB); PG8_STAGE_A(PG8_SA(0, 0), cA, 0, PG8_OC); PG8_STAGE_A(PG8_SA(0, 1), cA, 1, PG8_OC);
    if (wr == 1) PG8_BAR;
    PG8_WAIT_V(2); PG8_BAR;
    PG8_STAGE_B(PG8_SB(1, 0), cB + kstep); PG8_STAGE_A(PG8_SA(1, 0), cA + kstep, 0, PG8_OC); PG8_STAGE_B(PG8_SB(1, 1), cB + hstepB + kstep);
    PG8_WAIT_V(6); PG8_BAR;
    for (;;) {
        const bool has_next = S.next(ui + 1, nxt);
        const char* nA = has_next ? rfl_ptr(nxt.A) : cA; const char* nB = has_next ? rfl_ptr(nxt.B) : cB;
#pragma unroll 1
        for (int t = 0; t < nt; t += 2) {
            const bool last = (t == nt - 2);
            const char* a1 = cA + (size_t)(t + 1) * kstep;
            const char* a2 = last ? nA : cA + (size_t)(t + 2) * kstep; const char* b2 = last ? nB : cB + (size_t)(t + 2) * kstep;
            const char* a3 = a2 + kstep; const char* b3 = b2 + kstep;
            PG8_LDB(B0, 0, 0); PG8_LDB(B1, 0, 1); PG8_SCHED; PG8_LDA(At, 0, 0); PG8_STAGE_A(PG8_SA(1, 1), a1, 1, PG8_OC);
            if constexpr (GATHER) { if (last && has_next) { PG8_GIDX(gA, nxt); } }
            PG8_WAIT_V(8); PG8_WAIT_L(0); PG8_BAR; PG8_MMA(0, 0, At, B0); PG8_MMA(0, 1, At, B1); PG8_BAR; PG8_SCHED;
            PG8_LDA(At, 0, 1); PG8_STAGE_B(PG8_SB(0, 0), b2); PG8_STAGE_B(PG8_SB(0, 1), b2 + hstepB); PG8_STAGE_A(PG8_SA(0, 0), a2, 0, PG8_ON);
            PG8_WAIT_V(8); PG8_WAIT_L(0); PG8_BAR; PG8_MMA(1, 0, At, B0); PG8_MMA(1, 1, At, B1); PG8_BAR; PG8_SCHED;
            PG8_LDB(B0, 1, 0); PG8_LDB(B1, 1, 1); PG8_SCHED; PG8_LDA(At, 1, 0); PG8_STAGE_A(PG8_SA(0, 1), a2, 1, PG8_ON);
            PG8_WAIT_V(8); PG8_WAIT_L(0); PG8_BAR; PG8_MMA(0, 0, At, B0); PG8_MMA(0, 1, At, B1); PG8_BAR; PG8_SCHED;
            PG8_LDA(At, 1, 1); PG8_STAGE_B(PG8_SB(1, 0), b3); PG8_STAGE_B(PG8_SB(1, 1), b3 + hstepB); PG8_STAGE_A(PG8_SA(1, 0), a3, 0, PG8_ON);
            PG8_WAIT_V(8); PG8_WAIT_L(0); PG8_BAR; PG8_MMA(1, 0, At, B0); PG8_MMA(1, 1, At, B1); PG8_BAR; PG8_SCHED;
        }
        if constexpr (ALIGN_EPI) { if (wr == 0) PG8_BAR; }
        if constexpr (!Epi::AFTER_DRAIN) { E(acc, cur, wr, wc, fr, fq); }
        if (!has_next) break;
#pragma unroll
        for (int a = 0; a < 2; ++a)
#pragma unroll
            for (int b = 0; b < 2; ++b)
#pragma unroll
                for (int m = 0; m < 4; ++m)
#pragma unroll
                    for (int n = 0; n < 2; ++n) acc[a][b][m][n] = (f32x4){0.f, 0.f, 0.f, 0.f};
        cur = nxt; cA = nA; cB = nB; ++ui;
        if constexpr (ALIGN_EPI) { if (wr == 1) PG8_BAR; }
    }
    PG8_WAIT_V(0);
    if constexpr (!ALIGN_EPI) { if (wr == 0) PG8_BAR; }
    PG8_BAR;
    if constexpr (Epi::AFTER_DRAIN) { E.fused(acc, cur, wr, wc, fr, fq, lds, wid, lane); }
#undef PG8_SA
#undef PG8_SB
#undef PG8_GL
#undef PG8_STAGE_A
#undef PG8_STAGE_B
#undef PG8_LDA
#undef PG8_LDB
#undef PG8_MMA
#undef PG8_RD8
#undef PG8_WAIT_V
#undef PG8_WAIT_L
#undef PG8_BAR
#undef PG8_SCHED
#undef PG8_GIDX
#undef PG8_OC
#undef PG8_ON
}
}
#include <hip/hip_bf16.h>
#include <cmath>
namespace attn_body {
using bf16=__hip_bfloat16;
using bf16x8=__attribute__((ext_vector_type(8)))short;
using s16x4=__attribute__((ext_vector_type(4)))short;
using f32x16=__attribute__((ext_vector_type(16)))float;
using u32x4=__attribute__((ext_vector_type(4)))unsigned;
constexpr int SEQ=2048,D=64;
constexpr int NW=8,QBLK=32,QB=QBLK*NW,KVBLK=64,NQB=SEQ/QB;
constexpr int ATTN_UNIT_ROWS=QB;
struct AttnPtrs { const __hip_bfloat16* Q; const __hip_bfloat16* K; const __hip_bfloat16* V; __hip_bfloat16* O; int ldq, ldk, ldv, ldo; };
__device__ __forceinline__ int crow(int r,int hi){return (r&3)+8*(r>>2)+4*hi;}
#define SBAR() __builtin_amdgcn_sched_barrier(0)
__device__ __forceinline__ void cmask(f32x16&p0,f32x16&p1,int jb,int qrel,int hi){
  const float NEG=-INFINITY; int kb=64*jb+4*hi;
  #pragma unroll
  for(int r=0;r<16;++r){int kv=kb+(r&3)+8*(r>>2); if(kv>qrel)p0[r]=NEG; if(kv+32>qrel)p1[r]=NEG;}
}

constexpr int NSLOT=3, SLOTB=8192;
constexpr int LDS_K=0, LDS_V=NSLOT*SLOTB, LDS_WS=2*NSLOT*SLOTB, LDS_OST=LDS_WS+NW*64*4, LDS_BYTES=LDS_OST+NW*4096;
constexpr float C2=0.125f*1.4426950408889634f;
__device__ __forceinline__ void glds16(const void*gsrc,unsigned lds_dst){unsigned keep;
  asm volatile("s_mov_b32 %0, m0\n\ts_mov_b32 m0, %2\n\ts_nop 0\n\tglobal_load_lds_dwordx4 %1, off\n\ts_mov_b32 m0, %0":"=&s"(keep):"v"(gsrc),"s"(lds_dst):"memory");}
__device__ __forceinline__ float max3f(float a,float b,float c){float r;asm("v_max3_f32 %0, %1, %2, %3":"=v"(r):"v"(a),"v"(b),"v"(c));return r;}
__device__ __forceinline__ float max2f(float a,float b){float r;asm("v_max_f32_e32 %0, %1, %2":"=v"(r):"v"(a),"v"(b));return r;}
__device__ __forceinline__ float fadd_s(float a,float b){float r;asm("v_add_f32_e32 %0, %1, %2":"=v"(r):"v"(a),"v"(b));return r;}
__device__ __forceinline__ float fsub_s(float a,float b){float r;asm("v_sub_f32_e32 %0, %1, %2":"=v"(r):"v"(a),"v"(b));return r;}
typedef float f32x2_t __attribute__((ext_vector_type(2))); typedef __bf16 bf16x2_t __attribute__((ext_vector_type(2)));
__device__ __forceinline__ unsigned cvtpk_s(float lo,float hi){f32x2_t v={lo,hi};bf16x2_t b=__builtin_convertvector(v,bf16x2_t);return __builtin_bit_cast(unsigned,b);}
#define WAIT_BAR(N) asm volatile("s_waitcnt vmcnt(" #N ") lgkmcnt(0)\n\ts_barrier":::"memory")

__device__ __forceinline__ void qkt(f32x16&p0,f32x16&p1,const char*Kslot,const bf16x8*qr,const f32x16&negm,int r32,int hi){
  const char*kb=Kslot+hi*1024+r32*16;
  #pragma unroll
  for(int d0=0;d0<4;++d0){
    const bf16x8 b0=*reinterpret_cast<const bf16x8*>(kb+d0*2048);
    const bf16x8 b1=*reinterpret_cast<const bf16x8*>(kb+d0*2048+512);
    if(d0==0){p0=__builtin_amdgcn_mfma_f32_32x32x16_bf16(b0,qr[0],negm,0,0,0);p1=__builtin_amdgcn_mfma_f32_32x32x16_bf16(b1,qr[0],negm,0,0,0);}
    else{p0=__builtin_amdgcn_mfma_f32_32x32x16_bf16(b0,qr[d0],p0,0,0,0);p1=__builtin_amdgcn_mfma_f32_32x32x16_bf16(b1,qr[d0],p1,0,0,0);}}
}
typedef __attribute__((address_space(3))) const char* lds_cptr;
typedef short v4i16_t __attribute__((ext_vector_type(4)));
__device__ __forceinline__ void kload8(bf16x8*kf,lds_cptr kp){
  kf[0]=*(const __attribute__((address_space(3))) bf16x8*)(kp);      kf[1]=*(const __attribute__((address_space(3))) bf16x8*)(kp+512);
  kf[2]=*(const __attribute__((address_space(3))) bf16x8*)(kp+2048); kf[3]=*(const __attribute__((address_space(3))) bf16x8*)(kp+2560);
  kf[4]=*(const __attribute__((address_space(3))) bf16x8*)(kp+4096); kf[5]=*(const __attribute__((address_space(3))) bf16x8*)(kp+4608);
  kf[6]=*(const __attribute__((address_space(3))) bf16x8*)(kp+6144); kf[7]=*(const __attribute__((address_space(3))) bf16x8*)(kp+6656);
}
__device__ __forceinline__ void kload2(bf16x8*kf,lds_cptr kp,int j){ kf[2*j]=*(const __attribute__((address_space(3))) bf16x8*)(kp+j*2048); kf[2*j+1]=*(const __attribute__((address_space(3))) bf16x8*)(kp+j*2048+512); }
__device__ __forceinline__ s16x4 vtr(lds_cptr p){ return __builtin_bit_cast(s16x4,__builtin_amdgcn_ds_read_tr16_b64_v4i16((__attribute__((address_space(3))) v4i16_t*)p)); }
__device__ __forceinline__ float rowmax(const f32x16&p0,const f32x16&p1){
  float a=max3f(p0[0],p0[1],p1[0]),b=max3f(p0[2],p0[3],p1[1]);a=max3f(a,p1[2],p1[3]);
  #pragma unroll
  for(int r=4;r<16;r+=4){a=max3f(a,p0[r],p0[r+1]);b=max3f(b,p0[r+2],p0[r+3]);a=max3f(a,p1[r],p1[r+1]);b=max3f(b,p1[r+2],p1[r+3]);}
  const float m=max2f(a,b);
  auto rr=__builtin_amdgcn_permlane32_swap(__float_as_uint(m),__float_as_uint(m),false,false);
  return max2f(__uint_as_float(rr[0]),__uint_as_float(rr[1]));
}
__device__ __forceinline__ void pv(f32x16*o,int vb,bf16x8 pa0,bf16x8 pa1,bf16x8 pa2,bf16x8 pa3){
  #pragma unroll
  for(int d0=0;d0<2;++d0){s16x4 lo[4],hi[4];
    #pragma unroll
    for(int ks=0;ks<4;++ks){
      asm volatile("ds_read_b64_tr_b16 %0,%1 offset:%c2":"=&v"(lo[ks]):"v"(vb),"i"(d0*4096+ks*1024):"memory");
      asm volatile("ds_read_b64_tr_b16 %0,%1 offset:%c2":"=&v"(hi[ks]):"v"(vb),"i"(d0*4096+ks*1024+512):"memory");}
    asm volatile("s_waitcnt lgkmcnt(0)":::"memory");SBAR();
    #define PK(k) (bf16x8){lo[k][0],lo[k][1],lo[k][2],lo[k][3],hi[k][0],hi[k][1],hi[k][2],hi[k][3]}
    o[d0]=__builtin_amdgcn_mfma_f32_32x32x16_bf16(pa0,PK(0),o[d0],0,0,0);
    o[d0]=__builtin_amdgcn_mfma_f32_32x32x16_bf16(pa1,PK(1),o[d0],0,0,0);
    o[d0]=__builtin_amdgcn_mfma_f32_32x32x16_bf16(pa2,PK(2),o[d0],0,0,0);
    o[d0]=__builtin_amdgcn_mfma_f32_32x32x16_bf16(pa3,PK(3),o[d0],0,0,0);
    #undef PK
  }
}

#ifndef ATTN_STORE16
#define ATTN_STORE16(p,v) (*(u32x4*)(p)=(v))
#endif
template<int THRL> __device__ __forceinline__ void attn_unit(int qb,const AttnPtrs&P,char*shm){
  const int tid=threadIdx.x,lane=tid&63,r32=lane&31,hi=lane>>5; const int wid=__builtin_amdgcn_readfirstlane(tid>>6);
  const int q0=qb*QB; const long ldq=P.ldq,ldk=P.ldk,ldv=P.ldv,ldo=P.ldo;
  const bf16*Qw=P.Q+(long)(q0+wid*QBLK)*ldq;
  const bf16*Kh=P.K,*Vh=P.V;
  const unsigned lds0=(unsigned)(uintptr_t)shm;
  float*wsf=(float*)(shm+LDS_WS)+wid*64;
  const bf16*ksrc=Kh+(long)lane*ldk+wid*8;
  const bf16*vsrc=Vh+(long)(16*(wid&3)+(lane>>2))*ldv+(wid>>2)*32+(lane&3)*8;
  const unsigned kdst=lds0+LDS_K+wid*1024, vdst=lds0+LDS_V+wid*1024;
  #define DMA_K(t,slot) glds16(ksrc+(long)(t)*KVBLK*ldk,(unsigned)__builtin_amdgcn_readfirstlane(kdst+(slot)))
  #define DMA_V(t,slot) glds16(vsrc+(long)(t)*KVBLK*ldv,(unsigned)__builtin_amdgcn_readfirstlane(vdst+(slot)))
  const int vb0=(int)(lds0+LDS_V)+((lane>>4)&1)*32+(lane&3)*8+(4*hi+((lane&15)>>2))*64;
  const char*Kbase=shm+LDS_K; bf16x8 kf[8];
  const lds_cptr shm3=(lds_cptr)shm; const lds_cptr kp0=shm3+LDS_K+hi*1024+r32*16; const lds_cptr vp0=shm3+LDS_V+((lane>>4)&1)*32+(lane&3)*8+(4*hi+((lane&15)>>2))*64;
  constexpr int NT=SEQ/KVBLK;
  DMA_K(0,0);DMA_V(0,0);DMA_K(1,SLOTB);
  bf16x8 qr[4];
  #pragma unroll
  for(int d0=0;d0<4;++d0)qr[d0]=*reinterpret_cast<const bf16x8*>(&Qw[(long)r32*ldq+d0*16+hi*8]);
  float mhat=0.f,l_reg=0.f;f32x16 o[2];o[0]=f32x16{};o[1]=f32x16{};f32x16 negm=f32x16{};asm volatile("":"+v"(negm));
  #define CMASK(P0,P1,t) do{}while(0)
  bool resc=false;
  #define START(P0,P1) do{ const float rm=rowmax(P0,P1); resc=false; \
    { const float dl=rm; mhat=fadd_s(mhat,dl); \
      _Pragma("unroll") for(int r=0;r<16;++r){P0[r]=fsub_s(P0[r],dl);P1[r]=fsub_s(P1[r],dl);} \
      _Pragma("unroll") for(int r=0;r<16;++r)negm[r]=-mhat; asm volatile("":"+v"(negm)); } \
    _Pragma("unroll") for(int r=0;r<16;++r)P0[r]=__builtin_amdgcn_exp2f(P0[r]); }while(0)
  #define RESC() do{ if(resc){ asm volatile("s_waitcnt lgkmcnt(0)":::"memory"); \
      _Pragma("unroll") for(int d_=0;d_<2;++d_) _Pragma("unroll") for(int r=0;r<16;++r)o[d_][r]*=wsf[crow(r,hi)]; } }while(0)
  f32x16 pA0,pA1,pB0,pB1;
  int sl_prev=0,sl_cur=0,sl_next=SLOTB;
  #define ROT() do{sl_prev=sl_cur;sl_cur=sl_next;sl_next=(sl_next==(NSLOT-1)*SLOTB)?0:sl_next+SLOTB;}while(0)
  DMA_K(2,2*SLOTB);
  WAIT_BAR(3);
  qkt(pA0,pA1,Kbase,qr,negm,r32,hi);asm volatile("s_nop 15\n\ts_nop 7":"+v"(pA0),"+v"(pA1));CMASK(pA0,pA1,0);
  START(pA0,pA1);
  _Pragma("unroll") for(int r=0;r<16;++r)pA1[r]=__builtin_amdgcn_exp2f(pA1[r]);
  WAIT_BAR(0);
  DMA_K(3,0);DMA_V(1,SLOTB);
  ROT();
  kload8(kf,kp0+sl_cur);
  WAIT_BAR(2);
  s16x4 vlo[8],vhi[8]; u32x4 pw0,pw1,pw2,pw3;
  #define PKW(P,B) cvtpk_s(P[B],P[B+1])
  #define PAF(k) __builtin_bit_cast(bf16x8,pw##k)
  #define VFR(i) (bf16x8){vlo[i][0],vlo[i][1],vlo[i][2],vlo[i][3],vhi[i][0],vhi[i][1],vhi[i][2],vhi[i][3]}
  #define PIN(x) asm volatile("":"+v"(x))
  #define MX3(a,b,c) __builtin_fmaxf(__builtin_fmaxf((a),(b)),(c))
  #define GAPA(MF,A0,A1,A2,A3,W0,W1,PW) do{ MF; sacc+=A0; sacc+=A1; sacc+=A2; sacc+=A3; PIN(sacc); W0; W1; PIN(PW); SBAR(); }while(0)
  #define EX(v) __builtin_amdgcn_exp2f(v)
  #define GAPB(MF,X,B) do{ MF; X[B]=EX(X[B]); X[B+1]=EX(X[B+1]); X[B+2]=EX(X[B+2]); X[B+3]=EX(X[B+3]); PIN(X); SBAR(); }while(0)
  #define VRD(i) do{ vlo[i]=vtr(vp_+(((i)>>2)*4096+((i)&3)*1024)); vhi[i]=vtr(vp_+(((i)>>2)*4096+((i)&3)*1024+512)); }while(0)
  #define KRD(G,j) do{ if(G){ kload2(kf,kp0+sl_next,j); SBAR(); } }while(0)
  #define STEP(C0,C1,P0,P1,t,GK,GV,GL) do{ SBAR(); \
    const lds_cptr vp_=vp0+sl_prev; \
    VRD(0); SBAR(); float sacc=(P0[0]+P0[1]); \
    GAPA(C0=__builtin_amdgcn_mfma_f32_32x32x16_bf16(kf[0],qr[0],negm,0,0,0), P0[2],P0[3],P0[4],P0[5],     pw0[0]=PKW(P0,0), pw0[1]=PKW(P0,2), pw0); \
    VRD(4); SBAR(); GAPA(C1=__builtin_amdgcn_mfma_f32_32x32x16_bf16(kf[1],qr[0],negm,0,0,0), P0[6],P0[7],P0[8],P0[9],     pw0[2]=PKW(P0,4), pw0[3]=PKW(P0,6), pw0); \
    VRD(1); SBAR(); GAPA(C0=__builtin_amdgcn_mfma_f32_32x32x16_bf16(kf[2],qr[1],C0,0,0,0),   P0[10],P0[11],P0[12],P0[13], pw1[0]=PKW(P0,8), pw1[1]=PKW(P0,10), pw1); \
    VRD(5); SBAR(); GAPA(C1=__builtin_amdgcn_mfma_f32_32x32x16_bf16(kf[3],qr[1],C1,0,0,0),   P0[14],P0[15],P1[0],P1[1],   pw1[2]=PKW(P0,12),pw1[3]=PKW(P0,14), pw1); \
    VRD(2); SBAR(); GAPA(C0=__builtin_amdgcn_mfma_f32_32x32x16_bf16(kf[4],qr[2],C0,0,0,0),   P1[2],P1[3],P1[4],P1[5],     pw2[0]=PKW(P1,0), pw2[1]=PKW(P1,2), pw2); \
    VRD(6); SBAR(); GAPA(C1=__builtin_amdgcn_mfma_f32_32x32x16_bf16(kf[5],qr[2],C1,0,0,0),   P1[6],P1[7],P1[8],P1[9],     pw2[2]=PKW(P1,4), pw2[3]=PKW(P1,6), pw2); \
    VRD(3); SBAR(); GAPA(C0=__builtin_amdgcn_mfma_f32_32x32x16_bf16(kf[6],qr[3],C0,0,0,0),   P1[10],P1[11],P1[12],P1[13], pw3[0]=PKW(P1,8), pw3[1]=PKW(P1,10), pw3); \
    VRD(7); SBAR(); GAPA(C1=__builtin_amdgcn_mfma_f32_32x32x16_bf16(kf[7],qr[3],C1,0,0,0),   P1[14],P1[15],0.f,0.f,       pw3[2]=PKW(P1,12),pw3[3]=PKW(P1,14), pw3); \
    l_reg+=sacc; \
    if(GK){DMA_K((t)+3,sl_cur);} if(GV){DMA_V((t)+1,sl_next);} \
    CMASK(C0,C1,t); \
    { float a=MX3(C0[0],C0[1],C1[0]),b=MX3(C0[2],C0[3],C1[1]); a=MX3(a,C1[2],C1[3]); \
      _Pragma("unroll") for(int r=4;r<16;r+=4){a=MX3(a,C0[r],C0[r+1]);b=MX3(b,C0[r+2],C0[r+3]);a=MX3(a,C1[r],C1[r+1]);b=MX3(b,C1[r+2],C1[r+3]);} \
      float rm=__builtin_fmaxf(a,b); { auto rr=__builtin_amdgcn_permlane32_swap(__float_as_uint(rm),__float_as_uint(rm),false,false); rm=__builtin_fmaxf(__uint_as_float(rr[0]),__uint_as_float(rr[1])); } \
      resc=false; \
      if(__builtin_expect(__any(rm>(float)THRL),0)){ const float dl=__builtin_fmaxf(rm,0.f); mhat+=dl; \
        _Pragma("unroll") for(int r=0;r<16;++r){C0[r]-=dl;C1[r]-=dl;} \
        _Pragma("unroll") for(int r=0;r<16;++r)negm[r]=-mhat; asm volatile("":"+v"(negm)); \
        const float f=__builtin_amdgcn_exp2f(-dl); l_reg*=f; if(hi==0)wsf[r32]=f; resc=true; } } \
    SBAR(); \
    GAPB(o[0]=__builtin_amdgcn_mfma_f32_32x32x16_bf16(PAF(0),VFR(0),o[0],0,0,0), C0,0); \
    GAPB(o[1]=__builtin_amdgcn_mfma_f32_32x32x16_bf16(PAF(0),VFR(4),o[1],0,0,0), C0,4); \
    KRD(GL,0); GAPB(o[0]=__builtin_amdgcn_mfma_f32_32x32x16_bf16(PAF(1),VFR(1),o[0],0,0,0), C0,8); \
    KRD(GL,1); GAPB(o[1]=__builtin_amdgcn_mfma_f32_32x32x16_bf16(PAF(1),VFR(5),o[1],0,0,0), C0,12); \
    KRD(GL,2); GAPB(o[0]=__builtin_amdgcn_mfma_f32_32x32x16_bf16(PAF(2),VFR(2),o[0],0,0,0), C1,0); \
    KRD(GL,3); GAPB(o[1]=__builtin_amdgcn_mfma_f32_32x32x16_bf16(PAF(2),VFR(6),o[1],0,0,0), C1,4); \
    GAPB(o[0]=__builtin_amdgcn_mfma_f32_32x32x16_bf16(PAF(3),VFR(3),o[0],0,0,0), C1,8); \
    GAPB(o[1]=__builtin_amdgcn_mfma_f32_32x32x16_bf16(PAF(3),VFR(7),o[1],0,0,0), C1,12); \
    }while(0)
  int t=1;
  for(;t+5<NT;t+=2){
    STEP(pB0,pB1,pA0,pA1,t,true,true,true);     WAIT_BAR(2); RESC(); ROT();
    STEP(pA0,pA1,pB0,pB1,t+1,true,true,true);   WAIT_BAR(2); RESC(); ROT();
  }
  #define ENDW(tt) do{ if((tt)+3<NT){WAIT_BAR(2);} else if((tt)+2<NT){WAIT_BAR(1);} else {WAIT_BAR(0);} }while(0)
  for(;t+1<NT;t+=2){
    STEP(pB0,pB1,pA0,pA1,t,(t+3<NT),(t+1<NT),(t+1<NT));       ENDW(t);   RESC(); ROT();
    STEP(pA0,pA1,pB0,pB1,t+1,(t+4<NT),(t+2<NT),(t+2<NT));     ENDW(t+1); RESC(); ROT();
  }
  STEP(pB0,pB1,pA0,pA1,NT-1,false,false,false); RESC();
  { float sacc=pB0[0]+pB0[1]; _Pragma("unroll") for(int r=2;r<16;++r)sacc+=pB0[r]; _Pragma("unroll") for(int r=0;r<16;++r)sacc+=pB1[r]; l_reg+=sacc;
    pw0=(u32x4){PKW(pB0,0),PKW(pB0,2),PKW(pB0,4),PKW(pB0,6)};pw1=(u32x4){PKW(pB0,8),PKW(pB0,10),PKW(pB0,12),PKW(pB0,14)};pw2=(u32x4){PKW(pB1,0),PKW(pB1,2),PKW(pB1,4),PKW(pB1,6)};pw3=(u32x4){PKW(pB1,8),PKW(pB1,10),PKW(pB1,12),PKW(pB1,14)};
    SBAR(); pv(o,vb0+sl_cur,PAF(0),PAF(1),PAF(2),PAF(3)); }
  #undef PKW
  #undef PAF
  #undef VFR
  #undef PIN
  #undef MX3
  #undef GAPA
  #undef GAPB
  #undef EX
  #undef VRD
  #undef KRD
  #undef STEP
  #undef ENDW
  {auto rr=__builtin_amdgcn_permlane32_swap(__float_as_uint(l_reg),__float_as_uint(l_reg),false,false);l_reg=__uint_as_float(rr[0])+__uint_as_float(rr[1]);}
  if(hi==0)wsf[32+r32]=l_reg;asm volatile("s_waitcnt lgkmcnt(0)":::"memory");
  float rli[16];
  #pragma unroll
  for(int r=0;r<16;++r)rli[r]=__builtin_amdgcn_rcpf(wsf[32+crow(r,hi)]);
  bf16*Ow=P.O+(long)(q0+wid*QBLK)*ldo;
  { bf16*stg=(bf16*)(shm+LDS_OST)+wid*2048;
    #pragma unroll
    for(int r=0;r<16;++r){const int orow=crow(r,hi);
      #pragma unroll
      for(int d0=0;d0<2;++d0)stg[orow*64+d0*32+r32]=__float2bfloat16(o[d0][r]*rli[r]);}
    asm volatile("s_waitcnt lgkmcnt(0)":::"memory");
    #pragma unroll
    for(int i=0;i<4;++i){const int row=i*8+(lane>>3),ch=lane&7; const u32x4 v=*(const u32x4*)(stg+row*64+ch*8); ATTN_STORE16(Ow+(long)row*ldo+ch*8,v);} }
  asm volatile("s_waitcnt lgkmcnt(0)\n\ts_barrier":::"memory");
  #undef DMA_K
  #undef DMA_V
  #undef CMASK
  #undef START
  #undef RESC
  #undef ROT
}
constexpr int ATTN_LDS_BYTES=LDS_BYTES;
#undef SBAR
#undef WAIT_BAR
}

constexpr int NWAVES = 8;
constexpr int NB = 8, SEQ = 2048, D = 1024, M = NB * SEQ, MEMT = 256, DIN = 2304, NE = 32, TOPK = 4, CAP = M;
constexpr float ALPHA = 1.189207115002721f;
constexpr float LN_EPS = 1e-5f, RMS_EPS = 1e-6f, LAMBDA_INIT = 0.2f;
constexpr float LOG2E = 1.4426950408889634f;
constexpr float C2M = 0.0625f * LOG2E;
constexpr int HROWS = 73728;
constexpr int NPHASE = 17;
constexpr float WSCALE = 64.0f;

constexpr size_t MiB = 1u << 20;
constexpr size_t WS_CTL = 0, CTL_ZERO_BYTES = 1 * MiB;
constexpr size_t WS_WIN = 1 * MiB;
constexpr size_t WS_WMIX = 6 * MiB;
constexpr size_t WS_WQ = 8 * MiB;
constexpr size_t WS_WKV = 10 * MiB;
constexpr size_t WS_WO = 14 * MiB;
constexpr size_t WS_TAB = 16 * MiB;
constexpr size_t WS_WD = 17 * MiB;
constexpr size_t WS_WGU = 81 * MiB;
constexpr size_t WS_XB = 209 * MiB;
constexpr size_t WS_HRAW = 241 * MiB;
constexpr size_t WS_S = 241 * MiB, WS_X2 = 241 * MiB;
constexpr size_t WS_QA = 313 * MiB, WS_KA = 329 * MiB, WS_QB = 333 * MiB, WS_KB = 349 * MiB;
constexpr size_t WS_X1 = 313 * MiB;
constexpr size_t WS_OT = 377 * MiB;
constexpr size_t WS_QM = 377 * MiB, WS_P = 409 * MiB, WS_XO = 377 * MiB;
constexpr size_t WS_AO = 441 * MiB;
constexpr size_t WS_MEMK = 473 * MiB, WS_MEMVT = 477 * MiB, WS_MEMB = 481 * MiB;
constexpr size_t WS_LIST = 485 * MiB;
constexpr size_t WS_SEL = 487 * MiB;
constexpr size_t WS_H = 305 * MiB;
constexpr size_t WS_Y = 81 * MiB;
constexpr size_t WS_END = 512 * MiB;
constexpr int TB_COSS = 0, TB_SINS = 65536, TB_COSR = 131072, TB_SINR = 131584, TB_COSC = 132096, TB_SINC = 133120, TB_WRT = 134144;
constexpr int CW_TMO = 0, CW_CODE = 1, CW_CNT = 2048  , CW_BAR = 4096  ;

constexpr int RING_OFF = 0, RING_BYTES = 131072;
constexpr int IDX_OFF = RING_BYTES, IDX_BYTES = 12 * 1024;
constexpr int TILE_OFF = IDX_OFF + IDX_BYTES;
constexpr int TILE_BYTES = 320 * 4 + 32 * 4 + 32 * 4 + 16;
constexpr int LDSCTL_OFF = TILE_OFF + TILE_BYTES, MISC_OFF = LDSCTL_OFF + 64;
constexpr int LDS_BYTES = 147456;
static_assert(MISC_OFF + 128 <= LDS_BYTES, "LDS map");
#define GAS __attribute__((address_space(1)))
#define LAS __attribute__((address_space(3)))
typedef unsigned short bf16;
typedef unsigned v4u __attribute__((ext_vector_type(4)));
typedef float f32x4 __attribute__((ext_vector_type(4)));
typedef short bf16x8 __attribute__((ext_vector_type(8)));
typedef GAS unsigned gu32;
typedef GAS unsigned long long gu64;
#define RLX_AGENT __ATOMIC_RELAXED, __HIP_MEMORY_SCOPE_AGENT
#define LDS_WAIT() asm volatile("s_waitcnt lgkmcnt(0)" ::: "memory")
#define VM_WAIT() asm volatile("s_waitcnt vmcnt(0)" ::: "memory")
__device__ __forceinline__ unsigned long long rt() { return __builtin_amdgcn_s_memrealtime(); }
__device__ __forceinline__ unsigned f2bf(float f) { unsigned u = __builtin_bit_cast(unsigned, f); return (u + 0x7fffu + ((u >> 16) & 1u)) >> 16; }
__device__ __forceinline__ unsigned pk2(float lo, float hi) { return f2bf(lo) | (f2bf(hi) << 16); }

#define XB_TMO      128
#define XB_XCNT(j)  (256  + 64 * (j))
#define XB_XSUB(j)  (1280 + 64 * (j))
#define XB_XGEN(j)  (2304 + 64 * (j))
#define XB_TOP      3328
#define XB_TOPGEN   3392
#define XCD_BAR_WORDS 3456
#define XB_SPIN_CAP (1u << 18)

__device__ __forceinline__ unsigned xb_ld(unsigned* p)              { return __hip_atomic_load(p, __ATOMIC_RELAXED, __HIP_MEMORY_SCOPE_AGENT); }
__device__ __forceinline__ unsigned xb_add(unsigned* p, unsigned v) { return __hip_atomic_fetch_add(p, v, __ATOMIC_RELAXED, __HIP_MEMORY_SCOPE_AGENT); }
__device__ __forceinline__ unsigned xb_xcc_id() { return (unsigned)__builtin_amdgcn_s_getreg((3 << 11) | 20) & 0xFu; }
#define XB_SPIN(cond, bar) do { unsigned _sp = 0; while (cond) { __builtin_amdgcn_s_sleep(1); \
    if ((++_sp & 255u) == 0u) { if (xb_ld(&(bar)[XB_TMO])) break; if (_sp > XB_SPIN_CAP) { atomicAdd(&(bar)[XB_TMO], 1u); break; } } } } while (0)

struct XcdBarrier {
    unsigned* bar; unsigned x;
    volatile LAS unsigned* st;
};

__device__ __forceinline__ XcdBarrier xcd_barrier_post(unsigned* bar, volatile LAS unsigned* st) {
    XcdBarrier b; b.bar = bar; b.x = xb_xcc_id(); b.st = st;
    if (threadIdx.x == 0) (void)xb_add(&bar[XB_XCNT(b.x)], 1u);
    return b;
}
__device__ __forceinline__ void xcd_barrier_complete(unsigned* bar, unsigned x, unsigned& nloc, unsigned& nx) {
    const unsigned G = gridDim.x * gridDim.y * gridDim.z;
    unsigned sum, cnt, mine, sp = 0u;
    for (;;) {
        sum = 0u; cnt = 0u; mine = 0u;
#pragma unroll
        for (unsigned j = 0; j < 16; ++j) { const unsigned c = xb_ld(&bar[XB_XCNT(j)]); sum += c; cnt += (c > 0u) ? 1u : 0u; mine = (j == x) ? c : mine; }
        if (sum == G) break;
        __builtin_amdgcn_s_sleep(1);
        if ((++sp & 255u) == 0u) { if (xb_ld(&bar[XB_TMO])) break; if (sp > XB_SPIN_CAP) { atomicAdd(&bar[XB_TMO], 1u); break; } }
    }
    nloc = mine > 0u ? mine : 1u; nx = cnt > 0u ? cnt : 1u;
}

__device__ __forceinline__ void xcd_barrier(const XcdBarrier& b) {
    asm volatile("s_waitcnt vmcnt(0)" ::: "memory");
    __syncthreads();
    if (threadIdx.x == 0) {
        unsigned* bar = b.bar;
        __builtin_amdgcn_s_waitcnt(0);
        unsigned nloc = b.st[0], nx = b.st[1];
        if (nloc == 0u) { xcd_barrier_complete(bar, b.x, nloc, nx); b.st[0] = nloc; b.st[1] = nx; }
        const unsigned old = xb_add(&bar[XB_XSUB(b.x)], 1u);
        const unsigned gen = old / nloc;
        if (old + 1u == (gen + 1u) * nloc) {
            __builtin_amdgcn_fence(__ATOMIC_RELEASE, "agent");
            asm volatile("s_waitcnt vmcnt(0)" ::: "memory");
            const unsigned og = xb_add(&bar[XB_TOP], 1u);
            const unsigned tg = og / nx;
            if (og + 1u == (tg + 1u) * nx) xb_add(&bar[XB_TOPGEN], 1u);
            else XB_SPIN(xb_ld(&bar[XB_TOPGEN]) == tg, bar);
            __builtin_amdgcn_fence(__ATOMIC_ACQUIRE, "agent");
            xb_add(&bar[XB_XGEN(b.x)], 1u);
            asm volatile("s_waitcnt vmcnt(0)" ::: "memory");
        } else {
            XB_SPIN(xb_ld(&bar[XB_XGEN(b.x)]) == gen, bar);
            __builtin_amdgcn_fence(__ATOMIC_ACQUIRE, "agent");
            asm volatile("s_waitcnt vmcnt(0)" ::: "memory");
        }
    }
    __syncthreads();
}

struct Frame {
    LAS unsigned char* lds;
    volatile LAS unsigned* MISC;
    gu32* ctl;
    int tid, lane, wave, vcu, G;
    unsigned char* ws;
};
__device__ __forceinline__ float wave_sum(float v) {
#pragma unroll
    for (int o = 1; o < 64; o <<= 1) v += __shfl_xor(v, o);
    return v;
}
__device__ __forceinline__ float wave_max(float v) {
#pragma unroll
    for (int o = 1; o < 64; o <<= 1) v = fmaxf(v, __shfl_xor(v, o));
    return v;
}
__device__ __forceinline__ float bf2f(unsigned short b) { return __uint_as_float((unsigned)b << 16); }

struct P0Item { const float* src; unsigned char* dst; int N; int fp8; };
struct Ins { const float* p[28]; };
constexpr int P0_I_IN = 16 * 72, P0_I_SQ = 16 * 32, P0_I_KV = 16 * 64, P0_I_SMALL = P0_I_IN + 3 * P0_I_SQ + P0_I_KV, P0_NITEMS = P0_I_SMALL + NE * 3 * P0_I_SQ;
__device__ __forceinline__ P0Item p0_item(const Ins& I, unsigned char* ws, int it) {
    P0Item d; int r = it; d.fp8 = 0;
    if (r < P0_I_IN) { const int kb = r / 72, n0 = 32 * (r % 72); d.src = I.p[2] + (size_t)(64 * kb) * DIN + n0; d.N = DIN; d.dst = ws + WS_WIN + ((size_t)n0 * D + 64 * kb) * 2; return d; } r -= P0_I_IN;
    if (r < P0_I_SQ) { const int kb = r / 32, n0 = 32 * (r % 32); d.src = I.p[10] + (size_t)(64 * kb) * D + n0; d.N = D; d.dst = ws + WS_WMIX + ((size_t)n0 * D + 64 * kb) * 2; return d; } r -= P0_I_SQ;
    if (r < P0_I_SQ) { const int kb = r / 32, n0 = 32 * (r % 32); d.src = I.p[13] + (size_t)(64 * kb) * D + n0; d.N = D; d.dst = ws + WS_WQ + ((size_t)n0 * D + 64 * kb) * 2; return d; } r -= P0_I_SQ;
    if (r < P0_I_KV) { const int kb = r / 64, n0 = 32 * (r % 64); d.src = I.p[14] + (size_t)(64 * kb) * 2 * D + n0; d.N = 2 * D; d.dst = ws + WS_WKV + ((size_t)n0 * D + 64 * kb) * 2; return d; } r -= P0_I_KV;
    if (r < P0_I_SQ) { const int kb = r / 32, n0 = 32 * (r % 32); d.src = I.p[15] + (size_t)(64 * kb) * D + n0; d.N = D; d.dst = ws + WS_WO + ((size_t)n0 * D + 64 * kb) * 2; return d; } r -= P0_I_SQ;
    const int e = r / (3 * P0_I_SQ), q = r % (3 * P0_I_SQ), which = q / P0_I_SQ, jj = q % P0_I_SQ, kb = jj / 32, n0 = 32 * (jj % 32);
    d.fp8 = 1; d.N = D;
    if (which == 0)      { d.src = I.p[20] + (size_t)e * D * D + (size_t)(64 * kb) * D + n0; d.dst = ws + WS_WGU + (size_t)e * 2048 * D + (size_t)((n0 >> 7) * 256 + (n0 & 127)) * D + 64 * kb; }
    else if (which == 1) { d.src = I.p[22] + (size_t)e * D * D + (size_t)(64 * kb) * D + n0; d.dst = ws + WS_WGU + (size_t)e * 2048 * D + (size_t)((n0 >> 7) * 256 + 128 + (n0 & 127)) * D + 64 * kb; }
    else                 { d.src = I.p[24] + (size_t)e * D * D + (size_t)(64 * kb) * D + n0; d.dst = ws + WS_WD + (size_t)e * D * D + (size_t)n0 * D + 64 * kb; }
    return d;
}
__device__ __forceinline__ void p0_issue(const P0Item& d, float (&v)[32], int lane) {
    const float* s = d.src + (size_t)(lane >> 5) * d.N + (lane & 31);
#pragma unroll
    for (int i = 0; i < 32; ++i) v[i] = s[(size_t)(2 * i) * d.N];
}
__device__ __forceinline__ void p0_emit(const P0Item& d, const float (&v)[32], LAS float* scr, int lane) {
#pragma unroll
    for (int i = 0; i < 32; ++i) scr[(2 * i + (lane >> 5)) * 33 + (lane & 31)] = v[i];
    LDS_WAIT(); asm volatile("" ::: "memory");
    if (d.fp8) {
        const int c = lane & 3;
#pragma unroll
        for (int j = 0; j < 2; ++j) { const int n = (lane >> 2) + 16 * j; const LAS float* s = scr + (16 * c) * 33 + n;
            unsigned w[4];
#pragma unroll
            for (int q = 0; q < 4; ++q) { float a0 = s[(4 * q) * 33] * WSCALE, a1 = s[(4 * q + 1) * 33] * WSCALE, a2 = s[(4 * q + 2) * 33] * WSCALE, a3 = s[(4 * q + 3) * 33] * WSCALE;
                a0 = fminf(fmaxf(a0, -448.f), 448.f); a1 = fminf(fmaxf(a1, -448.f), 448.f); a2 = fminf(fmaxf(a2, -448.f), 448.f); a3 = fminf(fmaxf(a3, -448.f), 448.f);
                unsigned x = 0u; x = __builtin_amdgcn_cvt_pk_fp8_f32(a0, a1, x, false); x = __builtin_amdgcn_cvt_pk_fp8_f32(a2, a3, x, true); w[q] = x; }
            v4u o; o.x = w[0]; o.y = w[1]; o.z = w[2]; o.w = w[3];
            *(GAS v4u*)(d.dst + (size_t)n * D + 16 * c) = o; }
    } else {
        const int c = lane & 7;
#pragma unroll
        for (int j = 0; j < 4; ++j) { const int n = (lane >> 3) + 8 * j; const LAS float* s = scr + (8 * c) * 33 + n;
            v4u o; o.x = pk2(s[0 * 33], s[1 * 33]); o.y = pk2(s[2 * 33], s[3 * 33]); o.z = pk2(s[4 * 33], s[5 * 33]); o.w = pk2(s[6 * 33], s[7 * 33]);
            *(GAS v4u*)(d.dst + ((size_t)n * D + 8 * c) * 2) = o; }
    }
    LDS_WAIT(); asm volatile("" ::: "memory");
}
__device__ __forceinline__ void row_f32_to_bf16_2(const float* x0, bf16* o0, const float* x1, bf16* o1, int lane) {
    const GAS f32x4* a = (const GAS f32x4*)x0 + lane; const GAS f32x4* b = (const GAS f32x4*)x1 + lane;
    f32x4 va[4], vb[4];
#pragma unroll
    for (int j = 0; j < 4; ++j) { va[j] = a[64 * j]; vb[j] = b[64 * j]; }
    GAS unsigned long long* pa = (GAS unsigned long long*)o0 + lane; GAS unsigned long long* pb = (GAS unsigned long long*)o1 + lane;
#pragma unroll
    for (int j = 0; j < 4; ++j) { pa[64 * j] = (unsigned long long)pk2(va[j].x, va[j].y) | ((unsigned long long)pk2(va[j].z, va[j].w) << 32);
        pb[64 * j] = (unsigned long long)pk2(vb[j].x, vb[j].y) | ((unsigned long long)pk2(vb[j].z, vb[j].w) << 32); }
}
__device__ __forceinline__ void p0_prologue(Frame& F, const Ins& I) {
    LAS float* scr = (LAS float*)(F.lds + RING_OFF + F.wave * 16384);
    const int gw = F.vcu * NWAVES + F.wave, NGW = F.G * NWAVES;
    unsigned char* ws = F.ws;
    for (int m = gw; m < M; m += 2 * NGW) { const int m1 = (m + NGW < M) ? m + NGW : m; row_f32_to_bf16_2(I.p[0] + (size_t)m * D, (bf16*)(ws + WS_XB) + (size_t)m * D, I.p[0] + (size_t)m1 * D, (bf16*)(ws + WS_XB) + (size_t)m1 * D, F.lane); }
    for (int m = gw; m < NB * MEMT; m += 2 * NGW) { const int m1 = (m + NGW < NB * MEMT) ? m + NGW : m; row_f32_to_bf16_2(I.p[1] + (size_t)m * D, (bf16*)(ws + WS_MEMB) + (size_t)m * D, I.p[1] + (size_t)m1 * D, (bf16*)(ws + WS_MEMB) + (size_t)m1 * D, F.lane); }
    if (gw < P0_NITEMS) {
        float va[32], vb[32];
        P0Item da = p0_item(I, ws, gw), db = da; p0_issue(da, va, F.lane);
        for (int it = gw; it < P0_NITEMS; it += 2 * NGW) {
            const bool hb = it + NGW < P0_NITEMS; if (hb) { db = p0_item(I, ws, it + NGW); p0_issue(db, vb, F.lane); }
            p0_emit(da, va, scr, F.lane);
            const bool ha = it + 2 * NGW < P0_NITEMS; if (ha) { da = p0_item(I, ws, it + 2 * NGW); p0_issue(da, va, F.lane); }
            if (hb) p0_emit(db, vb, scr, F.lane);
        }
    }
    float* tab = (float*)(ws + WS_TAB);
    const int gt = F.vcu * (NWAVES * 64) + F.tid, NGT = F.G * NWAVES * 64;
    for (int i = gt; i < 65536; i += NGT) { const int s = i >> 5, f = i & 31; const float inv = powf(10000.0f, -(float)(2 * f) / 64.0f); const float ang = (float)s * inv; tab[TB_COSS + i] = cosf(ang); tab[TB_SINS + i] = sinf(ang); }
    for (int i = gt; i < 1536; i += NGT) {
        const bool isr = i < 512; const int j = isr ? i : i - 512, pos = j >> 4, f = j & 15; const float inv = powf(10000.0f, -(float)(2 * f) / 32.0f); const float ang = (float)pos * inv;
        if (isr) { tab[TB_COSR + j] = cosf(ang); tab[TB_SINR + j] = sinf(ang); } else { tab[TB_COSC + j] = cosf(ang); tab[TB_SINC + j] = sinf(ang); } }
    for (int i = gt; i < 32768; i += NGT) { const int e = i >> 10, k = i & 1023; tab[TB_WRT + i] = I.p[18][(size_t)k * NE + e]; }
}

struct SchedP1 {
    int G, c; const char* xb; const char* win; const char* memb; const char* wkv; bf16* hraw; bf16* memk; bf16* memvt;
    __device__ __forceinline__ bool next(int i, pg8::Unit& u) const {
        const long L = (long)i * G + c; u.gidx = 0; u.aux = 0;
        if (L < 576) { const int nM = 64, nN = 9, nwg = 576; int wgid = (int)L; { const int q = nwg / 8, xcd = wgid % 8, off = wgid / 8; wgid = xcd * q + off; }
            const int nig = 8 * nN, gid = wgid / nig, fm = gid * 8, gsz = (nM - fm) < 8 ? (nM - fm) : 8; const int pm = fm + ((wgid % nig) % gsz), pn = (wgid % nig) / gsz;
            u.A = xb + (size_t)pm * 256 * 2048; u.B = win + (size_t)pn * 256 * 2048; u.orow = pm * 256; u.ocol = pn * 256; u.O = hraw; u.ldo = DIN; return true; }
        if (L < 608) { const int j = (int)L - 576, pm = j >> 2, pn = j & 3; u.A = memb + (size_t)pm * 256 * 2048; u.B = wkv + (size_t)pn * 256 * 2048; u.orow = pm * 256; u.ocol = pn * 256; u.O = memk; u.ldo = D; return true; }
        if (L < 640) { const int j = (int)L - 608, b = j >> 2, pm = j & 3; u.A = wkv + (size_t)(1024 + pm * 256) * 2048; u.B = memb + (size_t)b * 256 * 2048; u.orow = b * 1024 + pm * 256; u.ocol = 0; u.O = memvt; u.ldo = 256; return true; }
        return false;
    }
};
struct SchedPlain {
    int nM, nN, nwg, G, c; const char* A; const char* B; size_t astep, bstep;
    __device__ __forceinline__ bool next(int i, pg8::Unit& u) const {
        const long L = (long)i * G + c; if (L >= nwg) return false;
        int wgid = (int)L; { const int q = nwg / 8, r = nwg % 8, xcd = wgid % 8, off = wgid / 8; wgid = (xcd < r ? xcd * (q + 1) : r * (q + 1) + (xcd - r) * q) + off; }
        const int nig = 8 * nN, gid = wgid / nig, fm = gid * 8, gsz = (nM - fm) < 8 ? (nM - fm) : 8; const int pm = fm + ((wgid % nig) % gsz), pn = (wgid % nig) / gsz;
        u.A = A + (size_t)pm * astep; u.B = B + (size_t)pn * bstep; u.orow = pm * 256; u.ocol = pn * 256; u.O = nullptr; u.ldo = 0; u.aux = 0; u.gidx = 0; return true;
    }
};

__device__ __forceinline__ void t1_unpack8(const v4u w, float (&v)[8]) {
    v[0] = __uint_as_float(w.x << 16); v[1] = __uint_as_float(w.x & 0xffff0000u); v[2] = __uint_as_float(w.y << 16); v[3] = __uint_as_float(w.y & 0xffff0000u);
    v[4] = __uint_as_float(w.z << 16); v[5] = __uint_as_float(w.z & 0xffff0000u); v[6] = __uint_as_float(w.w << 16); v[7] = __uint_as_float(w.w & 0xffff0000u);
}
__device__ __forceinline__ void t1_norm_rope(Frame& F, const Ins& I) {
    unsigned char* ws = F.ws; const int lane = F.lane, c = lane & 7;
    const bf16* hraw = (const bf16*)(ws + WS_HRAW); const float* tab = (const float*)(ws + WS_TAB);
    bf16* QA = (bf16*)(ws + WS_QA); bf16* KA = (bf16*)(ws + WS_KA); bf16* QB = (bf16*)(ws + WS_QB); bf16* KB = (bf16*)(ws + WS_KB);
    float gq[8], gk[8];
#pragma unroll
    for (int i = 0; i < 8; ++i) { gq[i] = I.p[3][8 * c + i]; gk[i] = I.p[4][8 * c + i]; }
    const int gw = F.vcu * NWAVES + F.wave, NGW = F.G * NWAVES;
    const float C2A = 0.125f * LOG2E;
    for (int grp = gw; grp < M / 8; grp += NGW) {
        const int t = grp * 8 + (lane >> 3), s = t & (SEQ - 1); const bf16* hr = hraw + (size_t)t * DIN + 8 * c;
        v4u wa[10], wb[16];
#pragma unroll
        for (int j = 0; j < 10; ++j) wa[j] = *(const GAS v4u*)(hr + j * 64);
#pragma unroll
        for (int j = 0; j < 16; ++j) wb[j] = *(const GAS v4u*)(hr + 768 + j * 64);
        {
            const int sub = c >> 2, pos = sub == 0 ? (s >> 6) : (s & 63); const float* ct = tab + (sub == 0 ? TB_COSR : TB_COSC) + pos * 16 + 8 * (c & 1); const float* st = tab + (sub == 0 ? TB_SINR : TB_SINC) + pos * 16 + 8 * (c & 1);
            float cs[8], sn[8];
#pragma unroll
            for (int i = 0; i < 8; ++i) { cs[i] = ct[i]; sn[i] = st[i]; }
            const bool first = (c & 3) < 2;
#pragma unroll
            for (int j = 0; j < 10; ++j) {
                float v[8]; t1_unpack8(wa[j], v);
                float ss = 0.f;
#pragma unroll
                for (int i = 0; i < 8; ++i) ss += v[i] * v[i];
                ss += __shfl_xor(ss, 1); ss += __shfl_xor(ss, 2); ss += __shfl_xor(ss, 4);
                const float r = 1.0f / sqrtf(ss * (1.0f / 64.0f) + RMS_EPS);
                float o[8];
#pragma unroll
                for (int i = 0; i < 8; ++i) { const float y = v[i] * r * (j < 8 ? gq[i] : gk[i]); const float pr = __shfl_xor(y, 2); o[i] = first ? (y * cs[i] - pr * sn[i]) : (y * cs[i] + pr * sn[i]); if (j < 8) o[i] *= C2A; }
                v4u w; w.x = pk2(o[0], o[1]); w.y = pk2(o[2], o[3]); w.z = pk2(o[4], o[5]); w.w = pk2(o[6], o[7]);
                if (j < 8) *(GAS v4u*)(QA + (size_t)t * 512 + j * 64 + 8 * c) = w; else *(GAS v4u*)(KA + (size_t)t * 128 + (j - 8) * 64 + 8 * c) = w;
            }
        }
        {
            const float* ct = tab + TB_COSS + s * 32 + 8 * (c & 3); const float* st = tab + TB_SINS + s * 32 + 8 * (c & 3);
            float cs[8], sn[8];
#pragma unroll
            for (int i = 0; i < 8; ++i) { cs[i] = ct[i]; sn[i] = st[i]; }
            const bool first = c < 4;
#pragma unroll
            for (int j = 0; j < 16; ++j) {
                float v[8]; t1_unpack8(wb[j], v);
                float o[8];
#pragma unroll
                for (int i = 0; i < 8; ++i) { const float pr = __shfl_xor(v[i], 4); o[i] = first ? (v[i] * cs[i] - pr * sn[i]) : (v[i] * cs[i] + pr * sn[i]); if (j < 8) o[i] *= C2A; }
                v4u w; w.x = pk2(o[0], o[1]); w.y = pk2(o[2], o[3]); w.z = pk2(o[4], o[5]); w.w = pk2(o[6], o[7]);
                if (j < 8) *(GAS v4u*)(QB + (size_t)t * 512 + j * 64 + 8 * c) = w; else *(GAS v4u*)(KB + (size_t)t * 512 + (j - 8) * 64 + 8 * c) = w;
            }
        }
    }
}

__device__ __forceinline__ bool attn_unit_ptrs(unsigned char* ws, long L, attn_body::AttnPtrs& P, int& qb) {
    using abf = __hip_bfloat16;
    if (L >= 1536) return false;
    const int r = (int)(L >> 8), v = (int)(L & 255), xcd = v >> 5, w = v & 31; qb = w & 7;
    if (r < 2) { const int idx = r * 8 + xcd, b = idx >> 1, g = idx & 1, h = g * 4 + (w >> 3);
        P.Q = (const abf*)(ws + WS_QA) + (size_t)b * SEQ * 512 + h * 64; P.ldq = 512;
        P.K = (const abf*)(ws + WS_KA) + (size_t)b * SEQ * 128 + g * 64; P.ldk = 128;
        P.V = (const abf*)(ws + WS_HRAW) + (size_t)b * SEQ * DIN + 640 + g * 64; P.ldv = DIN;
        P.O = (abf*)(ws + WS_AO) + (size_t)b * SEQ * 1024 + h * 64; P.ldo = 1024;
    } else { const int idx = (r - 2) * 8 + xcd, b = idx >> 2, h = idx & 3, c = w >> 4, vh = (w >> 3) & 1;
        P.Q = (const abf*)(ws + WS_QB) + (size_t)b * SEQ * 512 + (h * 2 + c) * 64; P.ldq = 512;
        P.K = (const abf*)(ws + WS_KB) + (size_t)b * SEQ * 512 + (h * 2 + c) * 64; P.ldk = 512;
        P.V = (const abf*)(ws + WS_HRAW) + (size_t)b * SEQ * DIN + 1792 + h * 128 + vh * 64; P.ldv = DIN;
        P.O = (abf*)(ws + WS_OT) + (size_t)c * M * 512 + (size_t)b * SEQ * 512 + h * 128 + vh * 64; P.ldo = 512;
    }
    return true;
}

__device__ __forceinline__ void t2_diff_combine(Frame& F, const Ins& I) {
    unsigned char* ws = F.ws; const int lane = F.lane, sub = lane & 15, grp = lane >> 4;
    const bf16* OT = (const bf16*)(ws + WS_OT); bf16* AO = (bf16*)(ws + WS_AO);
    const float lam = expf(wave_sum(I.p[5][lane] * I.p[6][lane])) - expf(wave_sum(I.p[7][lane] * I.p[8][lane])) + LAMBDA_INIT;
    float g[8];
#pragma unroll
    for (int j = 0; j < 8; ++j) g[j] = I.p[9][8 * sub + j] * (1.0f - LAMBDA_INIT);
    const int gw = F.vcu * NWAVES + F.wave, NGW = F.G * NWAVES;
    for (int it0 = gw; it0 < M; it0 += 2 * NGW) {
        v4u a[2], b[2]; int item[2];
#pragma unroll
        for (int u = 0; u < 2; ++u) { const int w = it0 + u * NGW; item[u] = (w < M) ? w * 4 + grp : -1;
            if (item[u] >= 0) { const size_t off = (size_t)(item[u] >> 2) * 512 + (item[u] & 3) * 128 + 8 * sub; a[u] = *(const GAS v4u*)(OT + off); b[u] = *(const GAS v4u*)(OT + (size_t)M * 512 + off); }
            else { a[u] = (v4u){0u, 0u, 0u, 0u}; b[u] = a[u]; } }
#pragma unroll
        for (int u = 0; u < 2; ++u) {
            float v[8]; const unsigned aw[4] = {a[u].x, a[u].y, a[u].z, a[u].w}, bw[4] = {b[u].x, b[u].y, b[u].z, b[u].w};
            float ss = 0.f;
#pragma unroll
            for (int q = 0; q < 4; ++q) { v[2 * q] = __uint_as_float(aw[q] << 16) - lam * __uint_as_float(bw[q] << 16); v[2 * q + 1] = __uint_as_float(aw[q] & 0xffff0000u) - lam * __uint_as_float(bw[q] & 0xffff0000u);
                ss += v[2 * q] * v[2 * q] + v[2 * q + 1] * v[2 * q + 1]; }
            ss += __shfl_xor(ss, 1); ss += __shfl_xor(ss, 2); ss += __shfl_xor(ss, 4); ss += __shfl_xor(ss, 8);
            const float r = 1.0f / sqrtf(ss * (1.0f / 128.0f) + RMS_EPS);
            if (item[u] >= 0) { v4u o; o.x = pk2(v[0] * r * g[0], v[1] * r * g[1]); o.y = pk2(v[2] * r * g[2], v[3] * r * g[3]); o.z = pk2(v[4] * r * g[4], v[5] * r * g[5]); o.w = pk2(v[6] * r * g[6], v[7] * r * g[7]);
                *(GAS v4u*)(AO + (size_t)(item[u] >> 2) * 1024 + 512 + (item[u] & 3) * 128 + 8 * sub) = o; }
        }
    }
}

template <bool Q8> __device__ __forceinline__ void ln_rows(Frame& F, float* X, float* XO, bf16* XB, const float* g, const float* bta) {
    const int lane = F.lane; const int gw = F.vcu * NWAVES + F.wave, NGW = F.G * NWAVES;
    f32x4 gg[4], bb[4];
#pragma unroll
    for (int j = 0; j < 4; ++j) { gg[j] = ((const GAS f32x4*)g)[lane + 64 * j]; bb[j] = ((const GAS f32x4*)bta)[lane + 64 * j]; }
    for (int m0 = gw; m0 < M; m0 += 2 * NGW) {
        f32x4 v[2][4]; int row[2];
#pragma unroll
        for (int u = 0; u < 2; ++u) { row[u] = (m0 + u * NGW < M) ? m0 + u * NGW : -1; const GAS f32x4* xr = (const GAS f32x4*)(X + (size_t)(row[u] < 0 ? m0 : row[u]) * D) + lane;
#pragma unroll
            for (int j = 0; j < 4; ++j) v[u][j] = xr[64 * j]; }
#pragma unroll
        for (int u = 0; u < 2; ++u) {
            float s = 0.f;
#pragma unroll
            for (int j = 0; j < 4; ++j) s += (v[u][j].x + v[u][j].y) + (v[u][j].z + v[u][j].w);
            const float mean = wave_sum(s) * (1.f / D); float s2 = 0.f;
#pragma unroll
            for (int j = 0; j < 4; ++j) { v[u][j] = v[u][j] - mean; s2 += (v[u][j].x * v[u][j].x + v[u][j].y * v[u][j].y) + (v[u][j].z * v[u][j].z + v[u][j].w * v[u][j].w); }
            const float rstd = 1.f / sqrtf(wave_sum(s2) * (1.f / D) + LN_EPS);
            if (row[u] >= 0) {
                GAS f32x4* xr = (GAS f32x4*)(XO + (size_t)row[u] * D) + lane;
                GAS unsigned long long* o8 = (GAS unsigned long long*)(XB + (size_t)row[u] * D) + lane;
                GAS unsigned* o4 = (GAS unsigned*)((unsigned char*)XB + (size_t)row[u] * D) + lane;
#pragma unroll
                for (int j = 0; j < 4; ++j) { const f32x4 o = v[u][j] * rstd * gg[j] + bb[j]; xr[64 * j] = o;
                    if constexpr (Q8) { unsigned x = 0u; x = __builtin_amdgcn_cvt_pk_fp8_f32(fminf(fmaxf(o.x, -448.f), 448.f), fminf(fmaxf(o.y, -448.f), 448.f), x, false);
                        x = __builtin_amdgcn_cvt_pk_fp8_f32(fminf(fmaxf(o.z, -448.f), 448.f), fminf(fmaxf(o.w, -448.f), 448.f), x, true); o4[64 * j] = x; }
                    else o8[64 * j] = (unsigned long long)pk2(o.x, o.y) | ((unsigned long long)pk2(o.z, o.w) << 32); }
            }
        }
    }
}

__device__ __forceinline__ void t4_softmax(Frame& F) {
    const float* S = (const float*)(F.ws + WS_S); bf16* P = (bf16*)(F.ws + WS_P); const int lane = F.lane;
    const int gw = F.vcu * NWAVES + F.wave, NGW = F.G * NWAVES;
    for (int r = gw; r < M * 4; r += NGW) {
        f32x4 v = ((const GAS f32x4*)(S + (size_t)r * 256))[lane];
        const float mx = wave_max(fmaxf(fmaxf(v.x, v.y), fmaxf(v.z, v.w)));
        v.x = __builtin_amdgcn_exp2f(v.x - mx); v.y = __builtin_amdgcn_exp2f(v.y - mx); v.z = __builtin_amdgcn_exp2f(v.z - mx); v.w = __builtin_amdgcn_exp2f(v.w - mx);
        const float rs = 1.0f / wave_sum((v.x + v.y) + (v.z + v.w));
        ((GAS unsigned long long*)(P + (size_t)r * 256))[lane] = (unsigned long long)pk2(v.x * rs, v.y * rs) | ((unsigned long long)pk2(v.z * rs, v.w * rs) << 32);
    }
}

__device__ __forceinline__ void t5b_router(Frame& F, const Ins& I, int dry) {
    unsigned char* ws = F.ws; const int lane = F.lane, fr = lane & 15, fq = lane >> 4;
    const float* X2 = (const float*)(ws + WS_X2); const float* wrT = (const float*)(ws + WS_TAB) + TB_WRT;
    int* list = (int*)(ws + WS_LIST); int* sel_e = (int*)(ws + WS_SEL); int* sel_pos = sel_e + M * 4; float* sel_g = (float*)(sel_pos + M * 4);
    LAS float* lgw = (LAS float*)(F.lds + RING_OFF + F.wave * 16384);
    const int khalf = F.wave >> 2, nblk = M / 16, stride = 4 * F.G, niter = (nblk + stride - 1) / stride;
    for (int it = 0; it < niter; ++it) {
        const int blk = it * stride + (F.wave & 3) * F.G + F.vcu; const bool live = blk < nblk; const int r0 = live ? blk * 16 : 0;
        const GAS f32x4* ap = (const GAS f32x4*)(X2 + (size_t)(r0 + fr) * D + khalf * 512 + 4 * fq);
        const GAS f32x4* b0p = (const GAS f32x4*)(wrT + (size_t)fr * D + khalf * 512 + 4 * fq);
        const GAS f32x4* b1p = (const GAS f32x4*)(wrT + (size_t)(16 + fr) * D + khalf * 512 + 4 * fq);
        f32x4 acc0 = {0.f, 0.f, 0.f, 0.f}, acc1 = {0.f, 0.f, 0.f, 0.f};
#pragma unroll 8
        for (int ks = 0; ks < 32; ++ks) {
            const f32x4 a = ap[4 * ks], b0 = b0p[4 * ks], b1 = b1p[4 * ks];
            acc0 = __builtin_amdgcn_mfma_f32_16x16x4f32(a.x, b0.x, acc0, 0, 0, 0); acc1 = __builtin_amdgcn_mfma_f32_16x16x4f32(a.x, b1.x, acc1, 0, 0, 0);
            acc0 = __builtin_amdgcn_mfma_f32_16x16x4f32(a.y, b0.y, acc0, 0, 0, 0); acc1 = __builtin_amdgcn_mfma_f32_16x16x4f32(a.y, b1.y, acc1, 0, 0, 0);
            acc0 = __builtin_amdgcn_mfma_f32_16x16x4f32(a.z, b0.z, acc0, 0, 0, 0); acc1 = __builtin_amdgcn_mfma_f32_16x16x4f32(a.z, b1.z, acc1, 0, 0, 0);
            acc0 = __builtin_amdgcn_mfma_f32_16x16x4f32(a.w, b0.w, acc0, 0, 0, 0); acc1 = __builtin_amdgcn_mfma_f32_16x16x4f32(a.w, b1.w, acc1, 0, 0, 0);
        }
#pragma unroll
        for (int r = 0; r < 4; ++r) { lgw[(4 * fq + r) * 33 + fr] = acc0[r]; lgw[(4 * fq + r) * 33 + 16 + fr] = acc1[r]; }
        __syncthreads();
        if (F.wave < 4 && live && lane < 16 && !dry) {
            const int t = r0 + lane; const LAS float* lo = lgw + lane * 33; const LAS float* hi = lo + 4 * 4096;
            float l[NE];
#pragma unroll
            for (int e = 0; e < NE; ++e) l[e] = (lo[e] + hi[e]) + I.p[19][e];
            int sel[TOPK]; float sv[TOPK];
#pragma unroll
            for (int k = 0; k < TOPK; ++k) {
                float best = -INFINITY; int bi = 0;
#pragma unroll
                for (int e = 0; e < NE; ++e) { const bool taken = (k > 0 && sel[0] == e) || (k > 1 && sel[1] == e) || (k > 2 && sel[2] == e); if (!taken && l[e] > best) { best = l[e]; bi = e; } }
                sel[k] = bi; sv[k] = best;
            }
            float ex[TOPK], sum = 0.f;
#pragma unroll
            for (int k = 0; k < TOPK; ++k) { ex[k] = expf(sv[k] - sv[0]); sum += ex[k]; }
            const float rs = 1.0f / sum;
#pragma unroll
            for (int k = 0; k < TOPK; ++k) {
                const int pos = (int)__hip_atomic_fetch_add((unsigned*)(F.ctl + CW_CNT + sel[k]), 1u, __ATOMIC_RELAXED, __HIP_MEMORY_SCOPE_AGENT);
                list[(size_t)sel[k] * CAP + pos] = t;
                sel_e[t * 4 + k] = sel[k]; sel_pos[t * 4 + k] = pos; sel_g[t * 4 + k] = ex[k] * rs;
            }
        }
        __syncthreads();
    }
}

__device__ __forceinline__ void moe_tables(Frame& F) {
    LAS int* tileE = (LAS int*)(F.lds + TILE_OFF); LAS int* tbase = tileE + 320; LAS int* cntS = tbase + 32; LAS int* Tp = cntS + 32;
    __syncthreads();
    if (F.tid < 32) cntS[F.tid] = (int)__hip_atomic_load((unsigned*)(F.ctl + CW_CNT + F.tid), __ATOMIC_RELAXED, __HIP_MEMORY_SCOPE_AGENT);
    __syncthreads();
    if (F.tid == 0) { int a = 0; for (int e = 0; e < NE; ++e) { tbase[e] = a; const int n = (cntS[e] + 255) >> 8; for (int j = 0; j < n; ++j) tileE[a + j] = e; a += n; } *Tp = a; }
    __syncthreads();
}
struct SchedGU {
    int vcu, T; LAS unsigned char* lds; const char* x2b; const char* wgu;
    __device__ __forceinline__ bool next(int i, pg8::Unit& u) const {
        const int tt = i * 32 + (vcu >> 3); if (tt >= T || i >= 12) return false;
        const int e = __builtin_amdgcn_readfirstlane(((const LAS int*)(lds + TILE_OFF))[tt]), pn = vcu & 7;
        u.A = x2b; u.B = wgu + ((size_t)e * 2048 + (size_t)pn * 256) * 1024; u.orow = tt * 256; u.ocol = pn * 128; u.O = nullptr; u.ldo = 0; u.aux = e; u.gidx = IDX_OFF + i * 1024; return true;
    }
};
struct SchedDown {
    int vcu, T; LAS unsigned char* lds; const char* h; const char* wd;
    __device__ __forceinline__ bool next(int i, pg8::Unit& u) const {
        const int tt = i * 64 + (vcu >> 2); if (tt >= T) return false;
        const int e = __builtin_amdgcn_readfirstlane(((const LAS int*)(lds + TILE_OFF))[tt]), pn = vcu & 3;
        u.A = h + (size_t)tt * 256 * 1024; u.B = wd + ((size_t)e * 1024 + (size_t)pn * 256) * 1024; u.orow = tt * 256; u.ocol = pn * 256; u.O = nullptr; u.ldo = 0; u.aux = e; u.gidx = 0; return true;
    }
};

__device__ __forceinline__ void t6_combine_ln(Frame& F, const Ins& I, float* out) {
    unsigned char* ws = F.ws; const int lane = F.lane;
    const float* X2 = (const float*)(ws + WS_X2); const bf16* Y = (const bf16*)(ws + WS_Y);
    const int* sel_e = (const int*)(ws + WS_SEL); const int* sel_pos = sel_e + M * 4; const float* sel_g = (const float*)(sel_pos + M * 4);
    const LAS int* tbase = (const LAS int*)(F.lds + TILE_OFF) + 320;
    const int gw = F.vcu * NWAVES + F.wave, NGW = F.G * NWAVES;
    f32x4 gg[4], bb[4];
#pragma unroll
    for (int j = 0; j < 4; ++j) { gg[j] = ((const GAS f32x4*)I.p[26])[lane + 64 * j]; bb[j] = ((const GAS f32x4*)I.p[27])[lane + 64 * j]; }
    for (int t0 = gw; t0 < M; t0 += 2 * NGW) {
        f32x4 x[2][4]; unsigned long long y[2][TOPK][4]; float gt[2][TOPK]; int tok[2];
#pragma unroll
        for (int u = 0; u < 2; ++u) { tok[u] = (t0 + u * NGW < M) ? t0 + u * NGW : -1; const int t = tok[u] < 0 ? t0 : tok[u];
            const GAS f32x4* xr = (const GAS f32x4*)(X2 + (size_t)t * D) + lane;
#pragma unroll
            for (int j = 0; j < 4; ++j) x[u][j] = xr[64 * j];
#pragma unroll
            for (int k = 0; k < TOPK; ++k) { const int e = sel_e[t * 4 + k], pos = sel_pos[t * 4 + k]; gt[u][k] = sel_g[t * 4 + k];
                const GAS unsigned long long* yr = (const GAS unsigned long long*)(Y + ((size_t)tbase[e] * 256 + pos) * D) + lane;
#pragma unroll
                for (int j = 0; j < 4; ++j) y[u][k][j] = yr[64 * j]; } }
#pragma unroll
        for (int u = 0; u < 2; ++u) {
            f32x4 v[4];
#pragma unroll
            for (int j = 0; j < 4; ++j) v[j] = x[u][j] * ALPHA;
#pragma unroll
            for (int k = 0; k < TOPK; ++k)
#pragma unroll
                for (int j = 0; j < 4; ++j) { const unsigned long long w = y[u][k][j]; const unsigned lo = (unsigned)w, hi = (unsigned)(w >> 32); const float g1 = gt[u][k];
                    v[j].x += g1 * __uint_as_float(lo << 16); v[j].y += g1 * __uint_as_float(lo & 0xffff0000u); v[j].z += g1 * __uint_as_float(hi << 16); v[j].w += g1 * __uint_as_float(hi & 0xffff0000u); }
            float s = 0.f;
#pragma unroll
            for (int j = 0; j < 4; ++j) s += (v[j].x + v[j].y) + (v[j].z + v[j].w);
            const float mean = wave_sum(s) * (1.f / D); float s2 = 0.f;
#pragma unroll
            for (int j = 0; j < 4; ++j) { v[j] = v[j] - mean; s2 += (v[j].x * v[j].x + v[j].y * v[j].y) + (v[j].z * v[j].z + v[j].w * v[j].w); }
            const float rstd = 1.f / sqrtf(wave_sum(s2) * (1.f / D) + LN_EPS);
            if (tok[u] >= 0) { GAS f32x4* orow = (GAS f32x4*)(out + (size_t)tok[u] * D) + lane;
#pragma unroll
                for (int j = 0; j < 4; ++j) orow[64 * j] = v[j] * rstd * gg[j] + bb[j]; }
        }
    }
}

struct Args { const float* in[28]; float* out; unsigned char* ws; int ph_lo, ph_hi, li, pad; };
__global__ void __launch_bounds__(NWAVES * 64, 2) mk_fwd(Args args) {
    extern __shared__ __attribute__((aligned(16))) unsigned char lds[];
    Frame F;
    F.lds = (LAS unsigned char*)lds;
    F.MISC = (volatile LAS unsigned*)(F.lds + MISC_OFF);
    F.tid = threadIdx.x; F.lane = F.tid & 63; F.wave = __builtin_amdgcn_readfirstlane(F.tid >> 6);
    F.G = gridDim.x; { const int bx = blockIdx.x; F.vcu = (F.G % 8 == 0) ? (bx % 8) * (F.G / 8) + bx / 8 : bx; }
    F.ws = args.ws; F.ctl = (gu32*)(args.ws + WS_CTL);
    unsigned char* ws = args.ws;
    Ins I;
#pragma unroll
    for (int i = 0; i < 28; ++i) I.p[i] = args.in[i];
    for (int u = F.tid; u < (LDS_BYTES - LDSCTL_OFF) / 4; u += NWAVES * 64) ((LAS unsigned*)(F.lds + LDSCTL_OFF))[u] = 0u;
    __syncthreads();
    const int lo = args.ph_lo, hi = args.ph_hi;
    XcdBarrier bar; bar.bar = (unsigned*)(F.ctl + CW_BAR) + args.li * XCD_BAR_WORDS; bar.x = 0; bar.st = nullptr;
    if (hi - lo > 1) bar = xcd_barrier_post((unsigned*)(F.ctl + CW_BAR) + args.li * XCD_BAR_WORDS, F.MISC + 8);
#define IN(k) (lo <= (k) && (k) < hi)
#ifndef REPMASK
#define REPMASK 0
#endif
#define PH(k, ...) do { if (IN(k)) { const int ph_rep = 0; (void)ph_rep; __VA_ARGS__ } if ((REPMASK >> (k)) & 1) { if (hi - lo > 1) xcd_barrier(bar); if (IN(k)) { const int ph_rep = 1; (void)ph_rep; __VA_ARGS__ } } } while (0)
#define SEAM(k) do { if (IN(k) && IN((k) + 1)) xcd_barrier(bar); } while (0)
    LAS unsigned char* ring = F.lds + RING_OFF;

    PH(0,  p0_prologue(F, I); ); SEAM(0);
    PH(1,
        pg8::Gemm g{2 * D, 2 * D, 2 * D}; SchedP1 S{F.G, (int)blockIdx.x, (const char*)(ws + WS_XB), (const char*)(ws + WS_WIN), (const char*)(ws + WS_MEMB), (const char*)(ws + WS_WKV), (bf16*)(ws + WS_HRAW), (bf16*)(ws + WS_MEMK), (bf16*)(ws + WS_MEMVT)};
        pg8::EpiBf16 E{nullptr, 0, nullptr, 0, 1.0f};
        pg8::gemm_phase<pg8::EpiBf16, SchedP1, true, false>(ring, F.lds, g, S, E);
    ); SEAM(1);
    PH(2,  t1_norm_rope(F, I); ); SEAM(2);
    PH(3,
        for (int i = 0;; ++i) { attn_body::AttnPtrs P; int qb; if (!attn_unit_ptrs(ws, (long)i * F.G + F.vcu, P, qb)) break; attn_body::attn_unit<8>(qb, P, (char*)lds + RING_OFF); }
    ); SEAM(3);
    PH(4,  t2_diff_combine(F, I); ); SEAM(4);
    PH(5,
        pg8::Gemm g{2 * D, 2 * D, 2 * D}; SchedPlain S{M / 256, 4, (M / 256) * 4, F.G, (int)blockIdx.x, (const char*)(ws + WS_AO), (const char*)(ws + WS_WMIX), (size_t)256 * 2048, (size_t)256 * 2048};
        pg8::EpiF32 E{(float*)(ws + WS_X1), I.p[0], D, ALPHA, 1.0f};
        pg8::gemm_phase<pg8::EpiF32, SchedPlain, true, false>(ring, F.lds, g, S, E);
    ); SEAM(5);
    PH(6,  ln_rows<false>(F, (float*)(ws + WS_X1), ph_rep ? (float*)(ws + WS_HRAW) : (float*)(ws + WS_X1), ph_rep ? (bf16*)(ws + WS_OT) : (bf16*)(ws + WS_XB), I.p[11], I.p[12]); ); SEAM(6);
#define WG_HANDOFF() do { asm volatile("s_waitcnt vmcnt(0)" ::: "memory"); __syncthreads(); if (F.wave == 0) { __builtin_amdgcn_fence(__ATOMIC_ACQUIRE, "agent"); asm volatile("s_waitcnt vmcnt(0)" ::: "memory"); } __syncthreads(); } while (0)
    PH(7, {
        struct SchedX { int G, c; const char* a; const char* b; int mode;
            __device__ __forceinline__ bool next(int i, pg8::Unit& u) const { const int L = i * G + c; if (L >= 256) return false; const int bb = L >> 5, h = (L >> 3) & 3, q = L & 7;
                u.orow = bb * SEQ + q * 256; u.ocol = h * 256; u.O = nullptr; u.ldo = 0; u.aux = 0; u.gidx = 0;
                if (mode == 0) { u.A = a + (size_t)(bb * SEQ + q * 256) * D * 2; u.B = b + (size_t)(h * 256) * D * 2; }
                else if (mode == 1) { u.A = a + ((size_t)(bb * SEQ + q * 256) * D + h * 256) * 2; u.B = b + ((size_t)(bb * MEMT) * D + h * 256) * 2; }
                else { u.A = a + ((size_t)(bb * SEQ + q * 256) * D + h * 256) * 2; u.B = b + ((size_t)(bb * 1024 + h * 256) * 256) * 2; }
                return true; } };
        { pg8::Gemm g{2 * D, 2 * D, 2 * D}; SchedX S{F.G, F.vcu, (const char*)(ws + WS_XB), (const char*)(ws + WS_WQ), 0};
          pg8::EpiBf16 E{(bf16*)(ws + WS_QM), D, nullptr, 0, C2M};
          pg8::gemm_phase<pg8::EpiBf16, SchedX, true, false>(ring, F.lds, g, S, E); }
        WG_HANDOFF();
        { pg8::Gemm g{2 * D, 2 * D, 512}; SchedX S{F.G, F.vcu, (const char*)(ws + WS_QM), (const char*)(ws + WS_MEMK), 1};
          pg8::EpiSoftmax E{(bf16*)(ws + WS_P), D};
          pg8::gemm_phase<pg8::EpiSoftmax, SchedX, true, false>(ring, F.lds, g, S, E); }
        WG_HANDOFF();
        { pg8::Gemm g{2 * D, 512, 512}; SchedX S{F.G, F.vcu, (const char*)(ws + WS_P), (const char*)(ws + WS_MEMVT), 2};
          pg8::EpiBf16 E{(bf16*)(ws + WS_XO), D, nullptr, 0, 1.0f};
          pg8::gemm_phase<pg8::EpiBf16, SchedX, true, false>(ring, F.lds, g, S, E); }
    }); SEAM(7);
#undef WG_HANDOFF
    PH(8, {}); PH(9, {}); PH(10, {});
#ifdef EXTRA_BAR
    if (hi - lo > 1) { for (int xb_ = 0; xb_ < EXTRA_BAR; ++xb_) xcd_barrier(bar); }
#endif
    PH(11,
        pg8::Gemm g{2 * D, 2 * D, 2 * D}; SchedPlain S{M / 256, 4, (M / 256) * 4, F.G, (int)blockIdx.x, (const char*)(ws + WS_XO), (const char*)(ws + WS_WO), (size_t)256 * 2048, (size_t)256 * 2048};
        pg8::EpiF32 E{(float*)(ws + WS_X2), (const float*)(ws + WS_X1), D, ALPHA, 1.0f};
        pg8::gemm_phase<pg8::EpiF32, SchedPlain, true, false>(ring, F.lds, g, S, E);
    ); SEAM(11);
    PH(12,  ln_rows<true>(F, (float*)(ws + WS_X2), ph_rep ? (float*)(ws + WS_X1) : (float*)(ws + WS_X2), ph_rep ? (bf16*)(ws + WS_OT) : (bf16*)(ws + WS_XB), I.p[16], I.p[17]); ); SEAM(12);
    PH(13,  t5b_router(F, I, ph_rep | args.pad); ); SEAM(13);
    PH(14,
        moe_tables(F);
        const LAS int* tileE = (const LAS int*)(F.lds + TILE_OFF); const LAS int* tbase = tileE + 320; const LAS int* cntS = tbase + 32; const int T = __builtin_amdgcn_readfirstlane(tbase[64]);
        const int* list = (const int*)(ws + WS_LIST);
        for (int i = 0; i < 12; ++i) { const int tt = i * 32 + (F.vcu >> 3); if (tt >= T) break;
            if (F.tid < 256) { const int e = tileE[tt], j = (tt - tbase[e]) * 256 + F.tid; ((LAS int*)(F.lds + IDX_OFF))[i * 256 + F.tid] = list[(size_t)e * CAP + (j < cntS[e] ? j : 0)]; } }
        __syncthreads();
        pg8::Gemm g{D, D, D};     SchedGU S{F.vcu, T, F.lds, (const char*)(ws + WS_XB), (const char*)(ws + WS_WGU)};
        pg8::EpiSwiglu E{ws + WS_H, D, I.p[21], I.p[23], 1.0f / WSCALE};
        pg8::gemm_phase<pg8::EpiSwiglu, SchedGU, true, true, true>(ring, F.lds, g, S, E);
    ); SEAM(14);
    PH(15,
        moe_tables(F);
        const int T = __builtin_amdgcn_readfirstlane(((const LAS int*)(F.lds + TILE_OFF))[320 + 64]);
        pg8::Gemm g{D, D, D};     SchedDown S{F.vcu, T, F.lds, (const char*)(ws + WS_H), (const char*)(ws + WS_WD)};
        pg8::EpiBf16 E{(bf16*)(ws + WS_Y), D, I.p[25], D, 1.0f / WSCALE};
        pg8::gemm_phase<pg8::EpiBf16, SchedDown, true, false, true>(ring, F.lds, g, S, E);
    ); SEAM(15);
    PH(16,  moe_tables(F); t6_combine_ln(F, I, args.out); );
#undef IN
#undef SEAM
}
#ifndef DBG_CUT
#define DBG_CUT 0
#endif
#if DBG_CUT
namespace v0 {
constexpr int NB = 8, SEQ = 2048, DM = 1024, NTOK = NB * SEQ, MEMT = 256, DIN = 2304, NE = 32, TOPK = 4, CAP = NTOK;
constexpr float ALPHA = 1.189207115002721f;
constexpr float LN_EPS = 1e-5f, RMS_EPS = 1e-6f;
constexpr float LAMBDA_INIT = 0.2f;

__device__ __forceinline__ float wave_sum(float v) {
#pragma unroll
    for (int o = 1; o < 64; o <<= 1) v += __shfl_xor(v, o);
    return v;
}
__device__ __forceinline__ float wave_max(float v) {
#pragma unroll
    for (int o = 1; o < 64; o <<= 1) v = fmaxf(v, __shfl_xor(v, o));
    return v;
}

struct GemmArgs {
    const float* A; const float* B; const float* B2; float* C;
    const float* bias; const float* bias2; const float* R;
    const int* rowidx; const int* Mdev; const int* offdev; const float* gate;
    float alpha;
    int M, N, K, lda, ldb, ldc, transB, nz2, aoff_dev, coff_dev;
    long a1, a2, b1, b2, c1, c2, bias1, idx1;
};

template <int MODE>
__global__ void __launch_bounds__(256) k_gemm(GemmArgs g) {
    __shared__ float As[16][68];
    __shared__ float Bs[16][68];
    __shared__ float Bs2[MODE == 2 ? 16 : 1][68];
    const int z = blockIdx.z, z1 = z / g.nz2, z2 = z % g.nz2;
    const int M = g.Mdev ? g.Mdev[z] : g.M;
    const int m0 = blockIdx.y * 64, n0 = blockIdx.x * 64;
    if (m0 >= M) return;
    const float* A = g.A + z1 * g.a1 + z2 * g.a2;
    const float* B = g.B + z1 * g.b1 + z2 * g.b2;
    const float* B2 = MODE == 2 ? g.B2 + z1 * g.b1 + z2 * g.b2 : nullptr;
    float* C = g.C + z1 * g.c1 + z2 * g.c2;
    const long doff = g.offdev ? (long)g.offdev[z] : 0;
    const long aoff = g.aoff_dev ? doff : 0, coff = g.coff_dev ? doff : 0;
    const int* idx = g.rowidx ? g.rowidx + (long)z * g.idx1 : nullptr;
    const int tid = threadIdx.x, tx = tid & 15, ty = tid >> 4;
    float acc[4][4], acc2[4][4];
#pragma unroll
    for (int i = 0; i < 4; ++i)
#pragma unroll
        for (int j = 0; j < 4; ++j) { acc[i][j] = 0.f; acc2[i][j] = 0.f; }
    for (int k0 = 0; k0 < g.K; k0 += 16) {
        {
            const int r = tid >> 2, kq = (tid & 3) * 4, m = m0 + r;
            float4 v = make_float4(0.f, 0.f, 0.f, 0.f);
            if (m < M) { const long row = (idx && MODE != 3) ? (long)idx[m] : (aoff + m); v = *(const float4*)(A + row * g.lda + k0 + kq); }
            As[kq + 0][r] = v.x; As[kq + 1][r] = v.y; As[kq + 2][r] = v.z; As[kq + 3][r] = v.w;
        }
        if (g.transB) {
            const int n = tid >> 2, kq = (tid & 3) * 4;
            float4 v = make_float4(0.f, 0.f, 0.f, 0.f);
            if (n0 + n < g.N) v = *(const float4*)(B + (long)(n0 + n) * g.ldb + k0 + kq);
            Bs[kq + 0][n] = v.x; Bs[kq + 1][n] = v.y; Bs[kq + 2][n] = v.z; Bs[kq + 3][n] = v.w;
        } else {
            const int k = tid >> 4, nq = (tid & 15) * 4;
            float4 v = make_float4(0.f, 0.f, 0.f, 0.f);
            if (n0 + nq < g.N) v = *(const float4*)(B + (long)(k0 + k) * g.ldb + n0 + nq);
            Bs[k][nq + 0] = v.x; Bs[k][nq + 1] = v.y; Bs[k][nq + 2] = v.z; Bs[k][nq + 3] = v.w;
            if (MODE == 2) {
                float4 w = *(const float4*)(B2 + (long)(k0 + k) * g.ldb + n0 + nq);
                Bs2[k][nq + 0] = w.x; Bs2[k][nq + 1] = w.y; Bs2[k][nq + 2] = w.z; Bs2[k][nq + 3] = w.w;
            }
        }
        __syncthreads();
#pragma unroll
        for (int kk = 0; kk < 16; ++kk) {
            float a[4], b[4], b2[4];
#pragma unroll
            for (int i = 0; i < 4; ++i) a[i] = As[kk][ty * 4 + i];
#pragma unroll
            for (int j = 0; j < 4; ++j) b[j] = Bs[kk][tx * 4 + j];
            if (MODE == 2) {
#pragma unroll
                for (int j = 0; j < 4; ++j) b2[j] = Bs2[kk][tx * 4 + j];
            }
#pragma unroll
            for (int i = 0; i < 4; ++i)
#pragma unroll
                for (int j = 0; j < 4; ++j) { acc[i][j] += a[i] * b[j]; if (MODE == 2) acc2[i][j] += a[i] * b2[j]; }
        }
        __syncthreads();
    }
    const float* bias = g.bias ? g.bias + (long)z * g.bias1 : nullptr;
    const float* bias2 = (MODE == 2 && g.bias2) ? g.bias2 + (long)z * g.bias1 : nullptr;
#pragma unroll
    for (int i = 0; i < 4; ++i) {
        const int m = m0 + ty * 4 + i;
        if (m >= M) continue;
#pragma unroll
        for (int j = 0; j < 4; ++j) {
            const int n = n0 + tx * 4 + j;
            if (n >= g.N) continue;
            float v = acc[i][j] + (bias ? bias[n] : 0.f);
            if (MODE == 0) { C[(coff + m) * g.ldc + n] = v; }
            else if (MODE == 1) { C[(coff + m) * g.ldc + n] = g.alpha * g.R[(long)m * g.ldc + n] + v; }
            else if (MODE == 2) {
                float gg = fminf(v, 7.0f);
                float uu = acc2[i][j] + (bias2 ? bias2[n] : 0.f);
                uu = fminf(fmaxf(uu, -7.0f), 7.0f);
                const float sg = 1.0f / (1.0f + expf(-1.702f * gg));
                C[(coff + m) * g.ldc + n] = gg * sg * (uu + 1.0f);
            } else if (MODE == 3) {
                const int tok = idx[m];
                const float gt = g.gate[(long)z * g.idx1 + m];
                atomicAdd(&C[(long)tok * g.ldc + n], gt * v);
            } else { C[(coff + m) * g.ldc + n] = v * g.alpha; }
        }
    }
}

__global__ void __launch_bounds__(256) k_norm_rope(const float* __restrict__ h, const float* __restrict__ gq, const float* __restrict__ gk,
                                                   float* QA, float* KA, float* QB, float* KB) {
    const int lane = threadIdx.x & 63, w = threadIdx.x >> 6;
    const long item = (long)blockIdx.x * 4 + w;
    if (item >= (long)NTOK * 26) return;
    const int t = (int)(item / 26), slot = (int)(item % 26), s = t % SEQ;
    const float* hr = h + (long)t * DIN;
    if (slot < 10) {
        const bool isq = slot < 8;
        const int col0 = isq ? slot * 64 : 512 + (slot - 8) * 64;
        const float v = hr[col0 + lane];
        const float ss = wave_sum(v * v);
        const float y = v * (1.0f / sqrtf(ss * (1.0f / 64.0f) + RMS_EPS)) * (isq ? gq[lane] : gk[lane]);
        const int sub = lane >> 5, j = lane & 31, i = j & 15;
        const int pos = sub == 0 ? (s >> 6) : (s & 63);
        const float inv = powf(10000.0f, -(float)(2 * i) / 32.0f);
        const float ang = (float)pos * inv;
        const float c = cosf(ang), sn = sinf(ang);
        const float p = __shfl_xor(y, 16);
        const float o = (j < 16) ? (y * c - p * sn) : (y * c + p * sn);
        if (isq) QA[(long)t * 512 + slot * 64 + lane] = o; else KA[(long)t * 128 + (slot - 8) * 64 + lane] = o;
    } else {
        const bool isq = slot < 18;
        const int hc = isq ? slot - 10 : slot - 18;
        const int col0 = (isq ? 768 : 1280) + hc * 64;
        const float v = hr[col0 + lane];
        const int i = lane & 31;
        const float inv = powf(10000.0f, -(float)(2 * i) / 64.0f);
        const float ang = (float)s * inv;
        const float c = cosf(ang), sn = sinf(ang);
        const float p = __shfl_xor(v, 32);
        const float o = (lane < 32) ? (v * c - p * sn) : (v * c + p * sn);
        if (isq) QB[(long)t * 512 + hc * 64 + lane] = o; else KB[(long)t * 512 + hc * 64 + lane] = o;
    }
}

template <int DV>
__global__ void __launch_bounds__(64) k_attn(const float* __restrict__ Q, int ldq, const float* __restrict__ K, int ldk, int kgroup,
                                             const float* __restrict__ V, int ldv, int vgroup, int vstride, float* O, int diffmode, float scale) {
    __shared__ float Ks[32][64];
    __shared__ float Vs[32][DV];
    const int lane = threadIdx.x, y = blockIdx.y, b = blockIdx.z;
    const long t = (long)b * SEQ + blockIdx.x * 64 + lane;
    const float* qp = Q + t * ldq + y * 64;
    const float* kb = K + (long)b * SEQ * ldk + (y / kgroup) * 64;
    const float* vb = V + (long)b * SEQ * ldv + (y / vgroup) * vstride;
    float q[64], o[DV];
#pragma unroll
    for (int d = 0; d < 64; d += 4) { const float4 v = *(const float4*)(qp + d); q[d] = v.x * scale; q[d + 1] = v.y * scale; q[d + 2] = v.z * scale; q[d + 3] = v.w * scale; }
#pragma unroll
    for (int d = 0; d < DV; ++d) o[d] = 0.f;
    float m = -INFINITY, l = 0.f;
    for (int kt = 0; kt < SEQ; kt += 32) {
        __syncthreads();
#pragma unroll
        for (int i = 0; i < 8; ++i) { const int e = i * 64 + lane, r = e >> 4, c4 = (e & 15) * 4; *(float4*)&Ks[r][c4] = *(const float4*)(kb + (long)(kt + r) * ldk + c4); }
#pragma unroll
        for (int i = 0; i < DV / 8; ++i) { const int e = i * 64 + lane, r = e / (DV / 4), c4 = (e % (DV / 4)) * 4; *(float4*)&Vs[r][c4] = *(const float4*)(vb + (long)(kt + r) * ldv + c4); }
        __syncthreads();
        for (int j = 0; j < 32; ++j) {
            float s = 0.f;
#pragma unroll
            for (int d = 0; d < 64; d += 4) { const float4 kv = *(const float4*)&Ks[j][d]; s += q[d] * kv.x + q[d + 1] * kv.y + q[d + 2] * kv.z + q[d + 3] * kv.w; }
            const float mn = fmaxf(m, s);
            const float corr = expf(m - mn), p = expf(s - mn);
            l = l * corr + p; m = mn;
#pragma unroll
            for (int d = 0; d < DV; d += 4) { const float4 vv = *(const float4*)&Vs[j][d];
                o[d] = o[d] * corr + p * vv.x; o[d + 1] = o[d + 1] * corr + p * vv.y; o[d + 2] = o[d + 2] * corr + p * vv.z; o[d + 3] = o[d + 3] * corr + p * vv.w; }
        }
    }
    const float rl = 1.0f / l;
    float* op;
    if (diffmode) op = O + (long)(y & 1) * ((long)NTOK * 512) + t * 512 + (y >> 1) * 128;
    else op = O + t * 1024 + y * 64;
#pragma unroll
    for (int d = 0; d < DV; d += 4) *(float4*)(op + d) = make_float4(o[d] * rl, o[d + 1] * rl, o[d + 2] * rl, o[d + 3] * rl);
}

__global__ void __launch_bounds__(256) k_diff_combine(const float* __restrict__ OT, const float* lq1, const float* lk1, const float* lq2, const float* lk2,
                                                      const float* __restrict__ subg, float* AO) {
    const int lane = threadIdx.x & 63, w = threadIdx.x >> 6;
    const long item = (long)blockIdx.x * 4 + w;
    if (item >= (long)NTOK * 4) return;
    const float lam = expf(wave_sum(lq1[lane] * lk1[lane])) - expf(wave_sum(lq2[lane] * lk2[lane])) + LAMBDA_INIT;
    const int t = (int)(item >> 2), hh = (int)(item & 3);
    const float* o1 = OT + (long)t * 512 + hh * 128;
    const float* o2 = o1 + (long)NTOK * 512;
    const float v0 = o1[lane] - lam * o2[lane], v1 = o1[lane + 64] - lam * o2[lane + 64];
    const float ss = wave_sum(v0 * v0 + v1 * v1);
    const float r = 1.0f / sqrtf(ss * (1.0f / 128.0f) + RMS_EPS);
    float* out = AO + (long)t * 1024 + 512 + hh * 128;
    out[lane] = v0 * r * subg[lane] * (1.0f - LAMBDA_INIT);
    out[lane + 64] = v1 * r * subg[lane + 64] * (1.0f - LAMBDA_INIT);
}

__global__ void __launch_bounds__(256) k_ln(const float* in, const float* __restrict__ g, const float* __restrict__ bta, float* out, float* out2, float a2, int rows) {
    const int lane = threadIdx.x & 63, w = threadIdx.x >> 6;
    const int row = blockIdx.x * 4 + w;
    if (row >= rows) return;
    const float4* xr = (const float4*)(in + (long)row * DM) + lane;
    float4 v[4]; float s = 0.f;
#pragma unroll
    for (int j = 0; j < 4; ++j) { v[j] = xr[64 * j]; s += (v[j].x + v[j].y) + (v[j].z + v[j].w); }
    const float mean = wave_sum(s) * (1.0f / DM); float s2 = 0.f;
#pragma unroll
    for (int j = 0; j < 4; ++j) { v[j].x -= mean; v[j].y -= mean; v[j].z -= mean; v[j].w -= mean; s2 += (v[j].x * v[j].x + v[j].y * v[j].y) + (v[j].z * v[j].z + v[j].w * v[j].w); }
    const float rstd = 1.0f / sqrtf(wave_sum(s2) * (1.0f / DM) + LN_EPS);
#pragma unroll
    for (int j = 0; j < 4; ++j) {
        const float4 gg = ((const float4*)g)[lane + 64 * j], bb = ((const float4*)bta)[lane + 64 * j];
        float4 o; o.x = v[j].x * rstd * gg.x + bb.x; o.y = v[j].y * rstd * gg.y + bb.y; o.z = v[j].z * rstd * gg.z + bb.z; o.w = v[j].w * rstd * gg.w + bb.w;
        ((float4*)(out + (long)row * DM))[lane + 64 * j] = o;
        if (out2) ((float4*)(out2 + (long)row * DM))[lane + 64 * j] = make_float4(a2 * o.x, a2 * o.y, a2 * o.z, a2 * o.w);
    }
}

__global__ void __launch_bounds__(256) k_softmax256(float* S, long nrows) {
    const int lane = threadIdx.x & 63, w = threadIdx.x >> 6;
    const long row = (long)blockIdx.x * 4 + w;
    if (row >= nrows) return;
    float4* p = (float4*)(S + row * 256) + lane;
    float4 v = *p;
    const float mx = wave_max(fmaxf(fmaxf(v.x, v.y), fmaxf(v.z, v.w)));
    v.x = expf(v.x - mx); v.y = expf(v.y - mx); v.z = expf(v.z - mx); v.w = expf(v.w - mx);
    const float r = 1.0f / wave_sum((v.x + v.y) + (v.z + v.w));
    v.x *= r; v.y *= r; v.z *= r; v.w *= r;
    *p = v;
}

__global__ void __launch_bounds__(256) k_topk(const float* __restrict__ logits, int* cnt, int* list, float* glist) {
    const int t = blockIdx.x * 256 + threadIdx.x;
    if (t >= NTOK) return;
    float lg[NE];
#pragma unroll
    for (int e = 0; e < NE; e += 4) { const float4 v = *(const float4*)(logits + (long)t * NE + e); lg[e] = v.x; lg[e + 1] = v.y; lg[e + 2] = v.z; lg[e + 3] = v.w; }
    int sel[TOPK]; float sv[TOPK];
#pragma unroll
    for (int k = 0; k < TOPK; ++k) {
        float best = -INFINITY; int bi = 0;
#pragma unroll
        for (int e = 0; e < NE; ++e) { const bool taken = (k > 0 && sel[0] == e) || (k > 1 && sel[1] == e) || (k > 2 && sel[2] == e); if (!taken && lg[e] > best) { best = lg[e]; bi = e; } }
        sel[k] = bi; sv[k] = best;
    }
    const float mx = sv[0];
    float ex[TOPK], sum = 0.f;
#pragma unroll
    for (int k = 0; k < TOPK; ++k) { ex[k] = expf(sv[k] - mx); sum += ex[k]; }
#pragma unroll
    for (int k = 0; k < TOPK; ++k) {
        const int pos = atomicAdd(&cnt[sel[k]], 1);
        list[(long)sel[k] * CAP + pos] = t;
        glist[(long)sel[k] * CAP + pos] = ex[k] / sum;
    }
}
__global__ void k_offsets(const int* cnt, int* off) {
    if (threadIdx.x == 0 && blockIdx.x == 0) { int a = 0; for (int e = 0; e < NE; ++e) { off[e] = a; a += cnt[e]; } }
}
}
#endif

#ifndef DBG_CUT
#define DBG_CUT 0
#endif
#ifndef MK_SPLIT
#define MK_SPLIT 0
#endif

#if DBG_CUT
__global__ void __launch_bounds__(256) k_bf16_to_f32(const unsigned short* in, float* out, long n) {
    const long i = (long)blockIdx.x * 256 + threadIdx.x; if (i < n) out[i] = __uint_as_float((unsigned)in[i] << 16);
}
__global__ void __launch_bounds__(256) k_scale(const float* in, float* out, float a, long n) {
    const long i = (long)blockIdx.x * 256 + threadIdx.x; if (i < n) out[i] = a * in[i];
}
static void v0_tail(int stage, void* const* d_in, float* out, char* ws, hipStream_t stream) {
    using namespace v0;
    constexpr size_t MiB = 1u << 20;
    const float* x = (const float*)d_in[0]; const float* mem = (const float*)d_in[1];
    const float* w_mix = (const float*)d_in[10]; const float* ln1g = (const float*)d_in[11]; const float* ln1b = (const float*)d_in[12];
    const float* w_mq = (const float*)d_in[13]; const float* w_mkv = (const float*)d_in[14]; const float* w_mo = (const float*)d_in[15];
    const float* ln2g = (const float*)d_in[16]; const float* ln2b = (const float*)d_in[17]; const float* w_r = (const float*)d_in[18]; const float* b_r = (const float*)d_in[19];
    const float* w_g = (const float*)d_in[20]; const float* b_g = (const float*)d_in[21]; const float* w_u = (const float*)d_in[22]; const float* b_u = (const float*)d_in[23];
    const float* w_d = (const float*)d_in[24]; const float* b_d = (const float*)d_in[25]; const float* ln3g = (const float*)d_in[26]; const float* ln3b = (const float*)d_in[27];
    float* X1 = (float*)(ws + 0); float* QM = (float*)(ws + 64 * MiB); float* AOf = QM; float* S = (float*)(ws + 128 * MiB); float* XO = (float*)(ws + 192 * MiB);
    float* KV = (float*)(ws + 392 * MiB); float* X2 = (float*)(ws + 448 * MiB); float* Y = (float*)(ws + 256 * MiB); float* HH = (float*)(ws + 0);
    int* cnt = (int*)(ws + 320 * MiB); int* off = cnt + 64; float* logits = (float*)(ws + 321 * MiB); int* list = (int*)(ws + 323 * MiB); float* glist = (float*)(ws + 325 * MiB);
    (void)hipMemsetAsync(cnt, 0, 1024, stream);
    auto gemm0 = [&](int mode, GemmArgs g, dim3 grid) {
        switch (mode) {
            case 0: hipLaunchKernelGGL(k_gemm<0>, grid, dim3(256), 0, stream, g); break;
            case 1: hipLaunchKernelGGL(k_gemm<1>, grid, dim3(256), 0, stream, g); break;
            case 2: hipLaunchKernelGGL(k_gemm<2>, grid, dim3(256), 0, stream, g); break;
            case 3: hipLaunchKernelGGL(k_gemm<3>, grid, dim3(256), 0, stream, g); break;
            default: hipLaunchKernelGGL(k_gemm<4>, grid, dim3(256), 0, stream, g); break;
        }
    };
    if (stage <= 1) {
        { GemmArgs g{}; g.A = AOf; g.B = w_mix; g.C = X1; g.R = x; g.alpha = ALPHA; g.M = NTOK; g.N = DM; g.K = DM; g.lda = DM; g.ldb = DM; g.ldc = DM; g.nz2 = 1; gemm0(1, g, dim3(DM / 64, NTOK / 64, 1)); }
        hipLaunchKernelGGL(k_ln, dim3(NTOK / 4), dim3(256), 0, stream, X1, ln1g, ln1b, X1, (float*)nullptr, 0.f, NTOK);
    }
    if (stage <= 2) {
        { GemmArgs g{}; g.A = mem; g.B = w_mkv; g.C = KV; g.M = NB * MEMT; g.N = 2048; g.K = DM; g.lda = DM; g.ldb = 2048; g.ldc = 2048; g.nz2 = 1; gemm0(0, g, dim3(2048 / 64, NB * MEMT / 64, 1)); }
        { GemmArgs g{}; g.A = X1; g.B = w_mq; g.C = QM; g.M = NTOK; g.N = DM; g.K = DM; g.lda = DM; g.ldb = DM; g.ldc = DM; g.nz2 = 1; gemm0(0, g, dim3(DM / 64, NTOK / 64, 1)); }
        { GemmArgs g{}; g.A = QM; g.B = KV; g.C = S; g.alpha = 0.0625f; g.M = SEQ; g.N = 256; g.K = 256; g.lda = DM; g.ldb = 2048; g.ldc = DM; g.transB = 1; g.nz2 = 4;
          g.a1 = (long)SEQ * DM; g.a2 = 256; g.b1 = (long)MEMT * 2048; g.b2 = 256; g.c1 = (long)SEQ * DM; g.c2 = 256; gemm0(4, g, dim3(4, SEQ / 64, NB * 4)); }
        hipLaunchKernelGGL(k_softmax256, dim3(NTOK * 4 / 4), dim3(256), 0, stream, S, (long)NTOK * 4);
        { GemmArgs g{}; g.A = S; g.B = KV + 1024; g.C = XO; g.M = SEQ; g.N = 256; g.K = 256; g.lda = DM; g.ldb = 2048; g.ldc = DM; g.nz2 = 4;
          g.a1 = (long)SEQ * DM; g.a2 = 256; g.b1 = (long)MEMT * 2048; g.b2 = 256; g.c1 = (long)SEQ * DM; g.c2 = 256; gemm0(0, g, dim3(4, SEQ / 64, NB * 4)); }
        { GemmArgs g{}; g.A = XO; g.B = w_mo; g.C = X2; g.R = X1; g.alpha = ALPHA; g.M = NTOK; g.N = DM; g.K = DM; g.lda = DM; g.ldb = DM; g.ldc = DM; g.nz2 = 1; gemm0(1, g, dim3(DM / 64, NTOK / 64, 1)); }
        hipLaunchKernelGGL(k_ln, dim3(NTOK / 4), dim3(256), 0, stream, X2, ln2g, ln2b, X2, Y, ALPHA, NTOK);
    } else {
        hipLaunchKernelGGL(k_scale, dim3(NTOK * DM / 256), dim3(256), 0, stream, X2, Y, ALPHA, (long)NTOK * DM);
    }
    { GemmArgs g{}; g.A = X2; g.B = w_r; g.C = logits; g.bias = b_r; g.M = NTOK; g.N = NE; g.K = DM; g.lda = DM; g.ldb = NE; g.ldc = NE; g.nz2 = 1; gemm0(0, g, dim3(1, NTOK / 64, 1)); }
    hipLaunchKernelGGL(k_topk, dim3(NTOK / 256), dim3(256), 0, stream, logits, cnt, list, glist);
    hipLaunchKernelGGL(k_offsets, dim3(1), dim3(64), 0, stream, cnt, off);
    { GemmArgs g{}; g.A = X2; g.B = w_g; g.B2 = w_u; g.C = HH; g.bias = b_g; g.bias2 = b_u; g.rowidx = list; g.Mdev = cnt; g.offdev = off; g.coff_dev = 1;
      g.M = NTOK; g.N = DM; g.K = DM; g.lda = DM; g.ldb = DM; g.ldc = DM; g.nz2 = 1; g.b1 = (long)DM * DM; g.bias1 = DM; g.idx1 = CAP; gemm0(2, g, dim3(DM / 64, NTOK / 64, NE)); }
    { GemmArgs g{}; g.A = HH; g.B = w_d; g.C = Y; g.bias = b_d; g.rowidx = list; g.Mdev = cnt; g.offdev = off; g.aoff_dev = 1; g.gate = glist;
      g.M = NTOK; g.N = DM; g.K = DM; g.lda = DM; g.ldb = DM; g.ldc = DM; g.nz2 = 1; g.b1 = (long)DM * DM; g.bias1 = DM; g.idx1 = CAP; gemm0(3, g, dim3(DM / 64, NTOK / 64, NE)); }
    hipLaunchKernelGGL(k_ln, dim3(NTOK / 4), dim3(256), 0, stream, Y, ln3g, ln3b, out, (float*)nullptr, 0.f, NTOK);
}
#endif

extern "C" void kernel_launch(void* const* d_in, const int* in_sizes, int n_in, void* d_out, int out_size, void* d_ws, size_t ws_size, hipStream_t stream) {
    static int grid = 0;
    if (grid == 0) {
        if (n_in != 28 || in_sizes[0] != M * D || out_size != M * D || ws_size < WS_END) { fprintf(stderr, "kernel_launch: unexpected shapes (n_in %d, in0 %d, out %d, ws %zu); nothing launched\n", n_in, n_in > 0 ? in_sizes[0] : -1, out_size, ws_size); grid = -1; return; }
        int dev = 0, cus = 0, per_cu = 0;
        if (hipGetDevice(&dev) != hipSuccess || hipDeviceGetAttribute(&cus, hipDeviceAttributeMultiprocessorCount, dev) != hipSuccess) { grid = -1; return; }
        if (hipFuncSetAttribute((const void*)mk_fwd, hipFuncAttributeMaxDynamicSharedMemorySize, LDS_BYTES) != hipSuccess) { fprintf(stderr, "kernel_launch: hipFuncSetAttribute failed\n"); grid = -1; return; }
        if (hipOccupancyMaxActiveBlocksPerMultiprocessor(&per_cu, (const void*)mk_fwd, NWAVES * 64, LDS_BYTES) != hipSuccess || per_cu < 1) { fprintf(stderr, "kernel_launch: occupancy query reports %d workgroups per CU\n", per_cu); }
        (void)hipGetLastError();
        grid = cus;
        if (grid != 256) fprintf(stderr, "kernel_launch: %d CUs (built for 256)\n", grid);
    }
    if (grid < 0) return;
    if (hipMemsetAsync((char*)d_ws + WS_CTL, 0, CTL_ZERO_BYTES, stream) != hipSuccess) return;
    Args a{};
    for (int i = 0; i < 28; ++i) a.in[i] = (const float*)d_in[i];
    a.out = (float*)d_out; a.ws = (unsigned char*)d_ws;
#if DBG_CUT == 1
    const int last_phase = 5;
#elif DBG_CUT == 2
    const int last_phase = 7;
#elif DBG_CUT == 3
    const int last_phase = 13;
#else
    const int last_phase = NPHASE;
#endif
#if MK_SPLIT
    for (int p = 0; p < last_phase; ++p) { a.ph_lo = p; a.ph_hi = p + 1; a.li = p; hipLaunchKernelGGL(mk_fwd, dim3(grid), dim3(NWAVES * 64), LDS_BYTES, stream, a); }
#else
    a.ph_lo = 0; a.ph_hi = last_phase; a.li = 0; hipLaunchKernelGGL(mk_fwd, dim3(grid), dim3(NWAVES * 64), LDS_BYTES, stream, a);
#ifdef PROBE_TWICE
    a.li = 1; a.pad = 1; hipLaunchKernelGGL(mk_fwd, dim3(grid), dim3(NWAVES * 64), LDS_BYTES, stream, a);
#endif
#endif
#if DBG_CUT
    {
        char* ws = (char*)d_ws; const size_t MiBh = 1u << 20;
#if DBG_CUT == 1
        hipLaunchKernelGGL(k_bf16_to_f32, dim3(M * D / 256), dim3(256), 0, stream, (const unsigned short*)(ws + WS_AO), (float*)(ws + 64 * MiBh), (long)M * D);
#elif DBG_CUT == 2
        (void)hipMemcpyAsync(ws + 0, ws + WS_X1, (size_t)M * D * 4, hipMemcpyDeviceToDevice, stream);
#else
        (void)hipMemcpyAsync(ws + 448 * MiBh, ws + WS_X2, (size_t)M * D * 4, hipMemcpyDeviceToDevice, stream);
#endif
        v0_tail(DBG_CUT, d_in, (float*)d_out, ws, stream);
    }
#endif
}
```
